# Optimizing an MI355X kernel written in HIP

```python
import math
import jax, jax.numpy as jnp
from jax import lax
import numpy as np

D_MODEL = 2048
BATCH = 4
SEQ = 2048
DEPTH = 2
DEC_BATCH = 128
DEC_SEQ = 1
PAST_LEN = 16384
PAGE_SIZE = 128

S5_WIDTH = D_MODEL // 2
S5_GROUP = 16
S5_GROUPS = S5_WIDTH // S5_GROUP
S5_STATE = 64
GLA_HEADS = 4
GLA_DK = D_MODEL // 16
GLA_DV = D_MODEL // 8
GLA_RANK = 16
GLA_GATE_NORM = 16.0
RET_HEADS = 8
RET_DK = D_MODEL // 16
RET_DV = D_MODEL // 16
ROPE_BASE = 10000.0
CHUNK = 64
N_BRANCH = 3
D_FF = -(-8 * D_MODEL // (3 * 256)) * 256
EPS = 1e-6
SPLITS = (S5_WIDTH,
          GLA_HEADS * GLA_DK, GLA_HEADS * GLA_DK, GLA_HEADS * GLA_DV, GLA_HEADS * GLA_DV, GLA_RANK,
          RET_HEADS * RET_DK, RET_HEADS * RET_DK, RET_HEADS * RET_DV, RET_HEADS * RET_DV,
          N_BRANCH * D_MODEL)
W_IN = sum(SPLITS)

kernel_name = 'hybrid_s5_gla_retnet_step'

F32 = jnp.float32


def rmsnorm(x, gain):
    xf = x.astype(F32)
    y = xf * lax.rsqrt(jnp.mean(xf * xf, axis=-1, keepdims=True) + EPS)
    return (y * gain.astype(F32)).astype(x.dtype)


def rotary(x, pos):
    half = x.shape[-1] // 2
    inv = 1.0 / (ROPE_BASE ** jnp.linspace(0.0, 1.0, half, dtype=F32))
    ang = pos[:, None] * inv[None, :]
    cos = jnp.cos(ang)[None, :, None, :]
    sin = jnp.sin(ang)[None, :, None, :]
    xp = x.reshape(x.shape[:-1] + (half, 2))
    xe, xo = xp[..., 0], xp[..., 1]
    return jnp.stack([xe * cos - xo * sin, xo * cos + xe * sin], axis=-1).reshape(x.shape)


def _complex_affine_combine(e1, e2):
    a1r, a1i, b1r, b1i = e1
    a2r, a2i, b2r, b2i = e2
    return (a2r * a1r - a2i * a1i, a2r * a1i + a2i * a1r,
            a2r * b1r - a2i * b1i + b2r, a2r * b1i + a2i * b1r + b2i)


def s5_scan(u, x0_re, x0_im, a_re, a_im, log_dt, b_re, b_im, c_re, c_im, d_skip):
    bsz, length, _ = u.shape
    ug = u.reshape(bsz, length, S5_GROUPS, S5_GROUP)
    dt = jnp.exp(log_dt.astype(F32))[:, None]
    ar, ai = a_re.astype(F32), a_im.astype(F32)
    mag = jnp.exp(ar * dt)
    abr, abi = mag * jnp.cos(ai * dt), mag * jnp.sin(ai * dt)
    den = ar * ar + ai * ai
    nr, ni = abr - 1.0, abi
    fr, fi = (nr * ar + ni * ai) / den, (ni * ar - nr * ai) / den
    br, bi = b_re.astype(F32), b_im.astype(F32)
    bbr = fr[..., None] * br - fi[..., None] * bi
    bbi = fr[..., None] * bi + fi[..., None] * br
    xr_in = jnp.einsum('blgn,gpn->blgp', ug, bbr)
    xi_in = jnp.einsum('blgn,gpn->blgp', ug, bbi)
    x0r, x0i = x0_re.astype(F32), x0_im.astype(F32)
    xr_in = xr_in.at[:, 0].add(abr * x0r - abi * x0i)
    xi_in = xi_in.at[:, 0].add(abr * x0i + abi * x0r)
    a_r = jnp.broadcast_to(abr, xr_in.shape)
    a_i = jnp.broadcast_to(abi, xi_in.shape)
    _, _, xr, xi = lax.associative_scan(_complex_affine_combine, (a_r, a_i, xr_in, xi_in), axis=1)
    y = (jnp.einsum('blgp,gnp->blgn', xr, c_re.astype(F32))
         - jnp.einsum('blgp,gnp->blgn', xi, c_im.astype(F32))
         + d_skip.astype(F32).reshape(S5_GROUPS, S5_GROUP) * ug)
    return y.reshape(bsz, length, S5_WIDTH), xr[:, -1], xi[:, -1]


def gated_linear_recurrence(q, k, v, g, s0):
    bsz, length, heads, dk = q.shape
    dv = v.shape[-1]
    c = CHUNK if length % CHUNK == 0 else length
    n = length // c

    def to_chunks(a):
        return a.reshape(bsz, n, c, heads, a.shape[-1]).transpose(1, 0, 3, 2, 4)

    mask = jnp.tril(jnp.ones((c, c), dtype=bool))[:, :, None]

    def step(s, inp):
        qi, ki, vi, gi = inp
        b = jnp.cumsum(gi, axis=2)
        diff = b[:, :, :, None, :] - b[:, :, None, :, :]
        decay = jnp.exp(jnp.where(mask, diff, -jnp.inf))
        scores = jnp.einsum('bhtk,bhsk,bhtsk->bhts', qi, ki, decay)
        o = (jnp.einsum('bhts,bhsv->bhtv', scores, vi)
             + jnp.einsum('bhtk,bhkv->bhtv', qi * jnp.exp(b), s))
        b_last = b[:, :, -1:, :]
        s_new = (jnp.exp(b_last[:, :, 0, :])[..., None] * s
                 + jnp.einsum('bhsk,bhsv->bhkv', ki * jnp.exp(b_last - b), vi))
        return s_new, o

    s_fin, o = lax.scan(step, s0.astype(F32), tuple(map(to_chunks, (q, k, v, g))))
    o = o.transpose(1, 0, 3, 2, 4).reshape(bsz, length, heads, dv)
    return o, s_fin


def trunk_layer(x, pos, st_s5_re, st_s5_im, st_gla, st_ret,
                norm_mix, w_in, s5_a_re, s5_a_im, s5_log_dt, s5_b_re, s5_b_im, s5_c_re, s5_c_im,
                s5_d, s5_w_glu, s5_b_glu, s5_w_out, gla_w_gate, gla_b_gate, gla_norm, gla_w_out,
                ret_w_out, w_mix_out, norm_ffn, w_ffn_gate, w_ffn_up, w_ffn_down):
    bsz, length, _ = x.shape
    h = rmsnorm(x, norm_mix)
    proj = jnp.einsum('bld,de->ble', h, w_in).astype(F32)
    cuts = np.cumsum(SPLITS)[:-1].tolist()
    u, gq, gk, gv, gr, glr, rq, rk, rv, rg, mg = jnp.split(proj, cuts, axis=-1)

    y5, new_s5_re, new_s5_im = s5_scan(u, st_s5_re, st_s5_im, s5_a_re, s5_a_im, s5_log_dt,
                                       s5_b_re, s5_b_im, s5_c_re, s5_c_im, s5_d)
    y5 = jax.nn.gelu(y5)
    y5 = y5 * jax.nn.sigmoid(jnp.einsum('blc,ce->ble', y5, s5_w_glu.astype(F32)) + s5_b_glu.astype(F32))
    br_s5 = jnp.einsum('blc,cd->bld', y5, s5_w_out.astype(F32))

    q = gq.reshape(bsz, length, GLA_HEADS, GLA_DK) * (GLA_DK ** -0.5)
    k = gk.reshape(bsz, length, GLA_HEADS, GLA_DK)
    v = gv.reshape(bsz, length, GLA_HEADS, GLA_DV)
    logit = jnp.einsum('blr,re->ble', glr, gla_w_gate.astype(F32)) + gla_b_gate.astype(F32)
    g = (jax.nn.log_sigmoid(logit) / GLA_GATE_NORM).reshape(bsz, length, GLA_HEADS, GLA_DK)
    o, new_gla = gated_linear_recurrence(q, k, v, g, st_gla)
    o = o * lax.rsqrt(jnp.mean(o * o, axis=-1, keepdims=True) + EPS) * gla_norm.astype(F32)
    o = o.reshape(bsz, length, GLA_HEADS * GLA_DV) * jax.nn.silu(gr)
    br_gla = jnp.einsum('blc,cd->bld', o, gla_w_out.astype(F32))

    q = rotary(rq.reshape(bsz, length, RET_HEADS, RET_DK), pos)
    k = rotary(rk.reshape(bsz, length, RET_HEADS, RET_DK), pos) * (RET_DK ** -0.5)
    v = rv.reshape(bsz, length, RET_HEADS, RET_DV)
    log_gamma = jnp.log1p(-jnp.power(2.0, -5.0 - jnp.arange(RET_HEADS, dtype=F32)))
    gdec = jnp.broadcast_to(log_gamma[None, None, :, None], (bsz, length, RET_HEADS, RET_DK))
    o, new_ret = gated_linear_recurrence(q, k, v, gdec, st_ret)
    mu = jnp.mean(o, axis=-1, keepdims=True)
    o = (o - mu) * lax.rsqrt(jnp.mean(jnp.square(o - mu), axis=-1, keepdims=True) + EPS)
    o = o.reshape(bsz, length, RET_HEADS * RET_DV) * jax.nn.silu(rg)
    br_ret = jnp.einsum('blc,cd->bld', o, ret_w_out.astype(F32))

    gates = jax.nn.sigmoid(mg).reshape(bsz, length, N_BRANCH, D_MODEL)
    merged = gates[:, :, 0] * br_s5 + gates[:, :, 1] * br_gla + gates[:, :, 2] * br_ret
    x = x + jnp.einsum('bld,de->ble', merged, w_mix_out.astype(F32)).astype(x.dtype)

    h2 = rmsnorm(x, norm_ffn)
    ff = jax.nn.silu(jnp.einsum('bld,df->blf', h2, w_ffn_gate)) * jnp.einsum('bld,df->blf', h2, w_ffn_up)
    x = x + jnp.einsum('blf,fd->bld', ff, w_ffn_down).astype(x.dtype)
    dt = x.dtype
    return (x, new_s5_re.astype(dt), new_s5_im.astype(dt), new_gla.astype(dt), new_ret.astype(dt))


def setup_inputs(seed: int = 0) -> dict:
    key = jax.random.key(seed)
    ks = jax.random.split(key, 30)

    def nrm(i, shape, scale):
        return jax.random.normal(ks[i], shape, F32) * scale

    glu_cols = GLA_HEADS * GLA_DK
    return {
        'x_prompt': nrm(0, (BATCH, SEQ, D_MODEL), 1.0),
        'x_sample': nrm(1, (DEC_BATCH, DEC_SEQ, D_MODEL), 1.0),
        'state_s5_re': nrm(2, (DEPTH, DEC_BATCH, S5_GROUPS, S5_STATE), 0.5),
        'state_s5_im': nrm(3, (DEPTH, DEC_BATCH, S5_GROUPS, S5_STATE), 0.5),
        'state_gla': nrm(4, (DEPTH, DEC_BATCH, GLA_HEADS, GLA_DK, GLA_DV), 1.0),
        'state_ret': nrm(5, (DEPTH, DEC_BATCH, RET_HEADS, RET_DK, RET_DV), 1.0),
        'norm_mix': 1.0 + nrm(6, (DEPTH, D_MODEL), 0.02),
        'w_in': nrm(7, (DEPTH, D_MODEL, W_IN), D_MODEL ** -0.5),
        's5_a_re': -0.5 + nrm(8, (DEPTH, S5_GROUPS, S5_STATE), 0.01),
        's5_a_im': jnp.pi * jnp.arange(S5_STATE, dtype=F32) + nrm(9, (DEPTH, S5_GROUPS, S5_STATE), 0.01),
        's5_log_dt': jax.random.uniform(ks[10], (DEPTH, S5_GROUPS), F32, minval=math.log(1e-3), maxval=math.log(1e-1)),
        's5_b_re': nrm(11, (DEPTH, S5_GROUPS, S5_STATE, S5_GROUP), (2 * S5_GROUP) ** -0.5),
        's5_b_im': nrm(12, (DEPTH, S5_GROUPS, S5_STATE, S5_GROUP), (2 * S5_GROUP) ** -0.5),
        's5_c_re': nrm(13, (DEPTH, S5_GROUPS, S5_GROUP, S5_STATE), (2 * S5_STATE) ** -0.5),
        's5_c_im': nrm(14, (DEPTH, S5_GROUPS, S5_GROUP, S5_STATE), (2 * S5_STATE) ** -0.5),
        's5_d': nrm(15, (DEPTH, S5_WIDTH), 1.0),
        's5_w_glu': nrm(16, (DEPTH, S5_WIDTH, S5_WIDTH), S5_WIDTH ** -0.5),
        's5_b_glu': nrm(17, (DEPTH, S5_WIDTH), 0.01),
        's5_w_out': nrm(18, (DEPTH, S5_WIDTH, D_MODEL), S5_WIDTH ** -0.5),
        'gla_w_gate': nrm(19, (DEPTH, GLA_RANK, glu_cols), GLA_RANK ** -0.5),
        'gla_b_gate': nrm(20, (DEPTH, glu_cols), 0.01),
        'gla_norm': 1.0 + nrm(21, (DEPTH, GLA_DV), 0.02),
        'gla_w_out': nrm(22, (DEPTH, GLA_HEADS * GLA_DV, D_MODEL), (GLA_HEADS * GLA_DV) ** -0.5),
        'ret_w_out': nrm(23, (DEPTH, RET_HEADS * RET_DV, D_MODEL), (RET_HEADS * RET_DV) ** -0.5),
        'w_mix_out': nrm(24, (DEPTH, D_MODEL, D_MODEL), D_MODEL ** -0.5),
        'norm_ffn': 1.0 + nrm(25, (DEPTH, D_MODEL), 0.02),
        'w_ffn_gate': nrm(26, (DEPTH, D_MODEL, D_FF), D_MODEL ** -0.5),
        'w_ffn_up': nrm(27, (DEPTH, D_MODEL, D_FF), D_MODEL ** -0.5),
        'w_ffn_down': nrm(28, (DEPTH, D_FF, D_MODEL), D_FF ** -0.5),
        'norm_final': 1.0 + nrm(29, (D_MODEL,), 0.02),
    }


def reference(x_prompt, x_sample, state_s5_re, state_s5_im, state_gla, state_ret,
              norm_mix, w_in, s5_a_re, s5_a_im, s5_log_dt, s5_b_re, s5_b_im, s5_c_re, s5_c_im,
              s5_d, s5_w_glu, s5_b_glu, s5_w_out, gla_w_gate, gla_b_gate, gla_norm, gla_w_out,
              ret_w_out, w_mix_out, norm_ffn, w_ffn_gate, w_ffn_up, w_ffn_down, norm_final):
    bp, lp, _ = x_prompt.shape
    pos_prompt = jnp.arange(lp, dtype=F32)
    pos_sample = PAST_LEN + jnp.arange(x_sample.shape[1], dtype=F32)
    zero_s5 = jnp.zeros((bp, S5_GROUPS, S5_STATE), F32)
    zero_gla = jnp.zeros((bp, GLA_HEADS, GLA_DK, GLA_DV), F32)
    zero_ret = jnp.zeros((bp, RET_HEADS, RET_DK, RET_DV), F32)
    hp, hs = x_prompt, x_sample
    p_s5r, p_s5i, p_gla, p_ret = [], [], [], []
    s_s5r, s_s5i, s_gla, s_ret = [], [], [], []
    for l in range(DEPTH):
        lw = (norm_mix[l], w_in[l], s5_a_re[l], s5_a_im[l], s5_log_dt[l], s5_b_re[l], s5_b_im[l],
              s5_c_re[l], s5_c_im[l], s5_d[l], s5_w_glu[l], s5_b_glu[l], s5_w_out[l], gla_w_gate[l],
              gla_b_gate[l], gla_norm[l], gla_w_out[l], ret_w_out[l], w_mix_out[l], norm_ffn[l],
              w_ffn_gate[l], w_ffn_up[l], w_ffn_down[l])
        hp, a, b, c, d = trunk_layer(hp, pos_prompt, zero_s5, zero_s5, zero_gla, zero_ret, *lw)
        p_s5r.append(a); p_s5i.append(b); p_gla.append(c); p_ret.append(d)
        hs, a, b, c, d = trunk_layer(hs, pos_sample, state_s5_re[l], state_s5_im[l], state_gla[l], state_ret[l], *lw)
        s_s5r.append(a); s_s5i.append(b); s_gla.append(c); s_ret.append(d)
    y_prompt = rmsnorm(hp, norm_final)
    y_sample = rmsnorm(hs, norm_final)
    return (y_prompt, y_sample,
            jnp.stack(p_s5r), jnp.stack(p_s5i), jnp.stack(p_gla), jnp.stack(p_ret),
            jnp.stack(s_s5r), jnp.stack(s_s5i), jnp.stack(s_gla), jnp.stack(s_ret))
```

```cpp
#include <hip/hip_runtime.h>
#include <hip/hip_cooperative_groups.h>
#include <cstdio>
namespace cg = cooperative_groups;

#define LAS __attribute__((address_space(3)))
typedef unsigned short bf16_t;
typedef short bf16x8 __attribute__((ext_vector_type(8)));
typedef float f32x4 __attribute__((ext_vector_type(4)));
typedef float f32x2 __attribute__((ext_vector_type(2)));
typedef unsigned u32x4 __attribute__((ext_vector_type(4)));
typedef unsigned u32x2 __attribute__((ext_vector_type(2)));

constexpr int DM = 2048, NPROMPT = 8192, NSAMP = 128, MROWS = 8320, MP = 8448, SEQ = 2048, NB = 4;
constexpr int NIN = 14592, DFF = 5632, WIN_SRC = 14352;
constexpr int OFF_U = 0, OFF_GQ = 1024, OFF_GK = 1536, OFF_GV = 2048, OFF_GR = 3072, OFF_RQ = 4096, OFF_RK = 5120, OFF_RV = 6144, OFF_RG = 7168, OFF_MG = 8192, OFF_GLR = 14336;
constexpr int LDS_BYTES = 131072 + 16;
#ifndef REP_PRE
#define REP_PRE 1
#endif
#ifndef REP_MIX
#define REP_MIX 1
#endif
#ifndef REP_INPROJ
#define REP_INPROJ 1
#endif
#ifndef REP_SYNC
#define REP_SYNC 0
#endif
#ifndef REP_S5
#define REP_S5 1
#endif
#ifndef REP_RS
#define REP_RS 1
#endif
#ifndef REP_UP
#define REP_UP 1
#endif
#ifndef REP_DN
#define REP_DN 1
#endif
#ifndef REP_MG
#define REP_MG 1
#endif
#ifndef REP_MO
#define REP_MO 1
#endif
#ifndef REP_POST
#define REP_POST 1
#endif
#ifndef REP_NORM
#define REP_NORM 1
#endif
#ifndef DBG_ZMASK
#define DBG_ZMASK 0
#endif

constexpr size_t SZ_WIN = (size_t)NIN * 2048 * 2, SZ_WGLU = (size_t)1024 * 1024 * 2, SZ_WBR = (size_t)2048 * 1024 * 2, SZ_WMIX = (size_t)2048 * 2048 * 2,
                 SZ_WGU = (size_t)11264 * 2048 * 2, SZ_WDN = (size_t)2048 * 5632 * 2;
constexpr size_t WS_WIN = 0;
constexpr size_t WS_WGLU = WS_WIN + 2 * SZ_WIN;
constexpr size_t WS_WS5O = WS_WGLU + 2 * SZ_WGLU;
constexpr size_t WS_WGLAO = WS_WS5O + 2 * SZ_WBR;
constexpr size_t WS_WRETO = WS_WGLAO + 2 * SZ_WBR;
constexpr size_t WS_WMIX = WS_WRETO + 2 * SZ_WBR;
constexpr size_t WS_WGU = WS_WMIX + 2 * SZ_WMIX;
constexpr size_t WS_WDN = WS_WGU + 2 * SZ_WGU;
constexpr size_t WS_XN = WS_WDN + 2 * SZ_WDN;
constexpr size_t WS_PROJ = WS_XN + (size_t)MP * 2048 * 2;
constexpr size_t WS_Y5G = WS_PROJ + (size_t)MP * NIN * 2;
constexpr size_t WS_ORAW = WS_Y5G + (size_t)MP * 1024 * 2;
constexpr size_t WS_AS5 = WS_ORAW + (size_t)MP * 2048 * 4;
constexpr size_t WS_AGLA = WS_AS5 + (size_t)MP * 1024 * 2;
constexpr size_t WS_ARET = WS_AGLA + (size_t)MP * 1024 * 2;
constexpr size_t WS_MERGED = WS_ARET + (size_t)MP * 1024 * 2;
constexpr size_t WS_X1 = WS_MERGED + (size_t)MP * 2048 * 2;
constexpr size_t WS_X2 = WS_X1 + (size_t)MP * 2048 * 4;
constexpr size_t WS_ROT = WS_X2 + (size_t)MP * 2048 * 4;
constexpr size_t WS_S5A = WS_ROT + (size_t)2049 * 64 * 8 + 512;
constexpr size_t WS_S5B = WS_S5A + (size_t)2 * 64 * 64 * 16;
constexpr size_t WS_S5C = WS_S5B + (size_t)2 * 64 * 64 * 16 * 8;
constexpr size_t WS_S5BM = WS_S5C + (size_t)2 * 64 * 16 * 128 * 2;
constexpr size_t WS_END = WS_S5BM + (size_t)2 * 64 * 2 * 128 * 16 * 2;
constexpr size_t WS_FF = WS_PROJ;
constexpr size_t WS_BAR = WS_END;
constexpr size_t WS_BCUM = WS_BAR + 16384;
constexpr size_t WS_TOTAL = WS_BCUM + (size_t)NPROMPT * 512 * 4;
static_assert(WS_TOTAL <= (size_t)940572672, "workspace budget");
static_assert((size_t)MP * DFF * 2 <= (size_t)MP * NIN * 2, "ff alias");

constexpr size_t O_Y = 0, O_PS5R = 17039360, O_PS5I = 17072128, O_PGLA = 17104896, O_PRET = 18153472, O_SS5R = 19202048, O_SS5I = 20250624, O_SGLA = 21299200, O_SRET = 54853632;

struct Params { const float* in[30]; float* out; unsigned char* ws; };
typedef const __attribute__((address_space(4))) Params* ParamsK;
__device__ __forceinline__ ParamsK fresh_params() { unsigned long long a = (unsigned long long)__builtin_amdgcn_kernarg_segment_ptr(); asm volatile("" : "+s"(a)); return (ParamsK)a; }
__device__ __forceinline__ int fresh_tid() { int t = threadIdx.x; asm volatile("" : "+v"(t)); return t; }
__device__ __forceinline__ int fresh_bid() { int t = blockIdx.x; asm volatile("" : "+s"(t)); return t; }

typedef __bf16 bf16x2_t __attribute__((ext_vector_type(2)));
__device__ __forceinline__ unsigned cvt_pk_bf16(float lo, float hi) { const f32x2 v = {lo, hi}; const bf16x2_t b = __builtin_convertvector(v, bf16x2_t); return __builtin_bit_cast(unsigned, b); }
__device__ __forceinline__ bf16_t f2bf(float f) { return (bf16_t)(cvt_pk_bf16(f, 0.f) & 0xffffu); }
__device__ __forceinline__ float bf2f(bf16_t b) { return __uint_as_float(((unsigned)b) << 16); }
__device__ __forceinline__ float bflo(unsigned u) { return __uint_as_float(u << 16); }
__device__ __forceinline__ float bfhi(unsigned u) { return __uint_as_float(u & 0xffff0000u); }
__device__ __forceinline__ float sigmoidf_(float x) { return __builtin_amdgcn_rcpf(1.0f + __expf(-x)); }
__device__ __forceinline__ float siluf_(float x) { return x * sigmoidf_(x); }
__device__ __forceinline__ float geluf_(float x) { return x * sigmoidf_(1.5957691216057308f * (x + 0.044715f * x * x * x)); }
__device__ __forceinline__ float logsigmoidf_(float x) { return fminf(x, 0.f) - __logf(1.0f + __expf(-fabsf(x))); }

struct XSrc { const float* a; const float* b; int split, valid;
    __device__ __forceinline__ const float* row(int r) const { return r < split ? a + (size_t)r * DM : b + (size_t)(r - split) * DM; } };

namespace pg8 {
constexpr int BM = 256, BK = 64, HALF = 128, HTB = HALF * BK * 2, STAGE_BYTES = 8 * HTB, NXCD = 8, WGM = 8;
__device__ __forceinline__ int lds_byte(int r, int c) { const int st = (r >> 4) * 2 + (c >> 5), rr = r & 15, cc = c & 31, ob = rr * 64 + cc * 2; return st * 1024 + (ob ^ (((ob >> 9) & 1) << 5)); }
__device__ __forceinline__ void stage_rc(int b, int& R, int& C) { const int st = b / 1024, sb = b % 1024, swz = sb ^ (((sb >> 9) & 1) << 5); R = (st >> 1) * 16 + swz / 64; C = (st & 1) * 32 + (swz % 64) / 2; }
__device__ __forceinline__ int perm32(int rho) { const int n = rho >> 4, i = rho & 15; return 8 * (i >> 2) + 4 * n + (i & 3); }

struct Unit { int pm, pn, z; };
struct Gemm { const bf16_t* A0; const bf16_t* A1; const bf16_t* A2; const bf16_t* B0; const bf16_t* B1; const bf16_t* B2; int lda, ldb, K; };
struct TileOrder {
    int nM, nN, nwg, G, c, nz, cut, shift;
    __device__ void init(int M, int N, int G_, int c_, int nz_) { nM = M / BM; nN = N / BM; nwg = nM * nN; G = G_; c = c_; nz = nz_; cut = 1 << 30; shift = 0; }
    __device__ bool next(int i, Unit& u) const {
        const int it = i / nz; u.z = i - it * nz;
        const long L = (long)it * G + c; if (c < 0 || L >= nwg) return false;
        int wgid = (int)L; { const int q = nwg / NXCD, r = nwg % NXCD, xcd = wgid % NXCD, off = wgid / NXCD; wgid = (xcd < r ? xcd * (q + 1) : r * (q + 1) + (xcd - r) * q) + off; }
        const int nig = WGM * nN, gid = wgid / nig, fm = gid * WGM, gsz = (nM - fm) < WGM ? (nM - fm) : WGM;
        u.pm = fm + ((wgid % nig) % gsz); u.pn = (wgid % nig) / gsz; if (u.pn >= cut) u.pn += shift; return true;
    }
};

template <class Epi>
__device__ __forceinline__ void gemm_phase(LAS unsigned char* lds, const Gemm g, const TileOrder& S, const Epi& E) {
    const int tid = fresh_tid(), wid = __builtin_amdgcn_readfirstlane(tid >> 6), lane = tid & 63, wr = wid >> 2, wc = wid & 3, fr = lane & 15, fq = lane >> 4;
    const int K = g.K, nt = K / BK;
    unsigned voffA[2], voffB[2];
#pragma unroll
    for (int i = 0; i < 2; ++i) { int R, C; stage_rc(tid * 16 + i * 8192, R, C); const int Rb = Epi::PERM ? ((R & ~31) + perm32(R & 31)) : R;
        voffA[i] = (unsigned)(R * g.lda + C) * 2u; voffB[i] = (unsigned)(Rb * g.ldb + C) * 2u; }
    const size_t kstep = (size_t)(BK * 2);
    const size_t hstepA = (size_t)HALF * g.lda * 2, hstepB = (size_t)HALF * g.ldb * 2;
    const size_t tstepA = 2 * hstepA, tstepB = 2 * hstepB;
    const unsigned ldsw = (unsigned)wid * 1024u;
    const int aoff = lds_byte(wr * 64 + fr, fq * 8), boff = lds_byte(wc * 32 + fr, fq * 8);
#define PG8_SA(b, h) (((b) * 2 + (h)) * HTB)
#define PG8_SB(b, h) ((4 + (b) * 2 + (h)) * HTB)
#define PG8_STAGE(bufoff, gbase, voff) do { _Pragma("unroll") for (int _i = 0; _i < 2; ++_i) \
        __builtin_amdgcn_global_load_lds((const unsigned*)((const char*)(gbase) + (voff)[_i]), (LAS unsigned*)(lds + (bufoff) + ldsw + _i * 8192), 16, 0, 0); } while (0)
#define PG8_LDA(dst, b, h) do { _Pragma("unroll") for (int m = 0; m < 4; ++m) _Pragma("unroll") for (int k = 0; k < 2; ++k) dst[m][k] = *(const LAS bf16x8*)(lds + PG8_SA(b, h) + aoff + m * 2048 + k * 1024); } while (0)
#define PG8_LDB(dst, b, h) do { _Pragma("unroll") for (int n = 0; n < 2; ++n) _Pragma("unroll") for (int k = 0; k < 2; ++k) dst[n][k] = *(const LAS bf16x8*)(lds + PG8_SB(b, h) + boff + n * 2048 + k * 1024); } while (0)
#define PG8_MMA(ai, bj, At, Bt) do { __builtin_amdgcn_s_setprio(1); _Pragma("unroll") for (int m = 0; m < 4; ++m) _Pragma("unroll") for (int n = 0; n < 2; ++n) _Pragma("unroll") for (int k = 0; k < 2; ++k) \
        acc[ai][bj][m][n] = __builtin_amdgcn_mfma_f32_16x16x32_bf16(Bt[n][k], At[m][k], acc[ai][bj][m][n], 0, 0, 0); __builtin_amdgcn_s_setprio(0); } while (0)
#define PG8_WAIT_V(n) asm volatile("s_waitcnt vmcnt(" #n ")" ::: "memory")
#define PG8_WAIT_L(n) asm volatile("s_waitcnt lgkmcnt(" #n ")" ::: "memory")
#define PG8_BAR __builtin_amdgcn_s_barrier()
#define PG8_SCHED __builtin_amdgcn_sched_barrier(0)
#define PG8_BASEA(z) ((const char*)((z) == 0 ? g.A0 : ((z) == 1 ? g.A1 : g.A2)))
#define PG8_BASEB(z) ((const char*)((z) == 0 ? g.B0 : ((z) == 1 ? g.B1 : g.B2)))
    Unit cur, nxt; int ui = 0;
    if (!S.next(0, cur)) return;
    f32x4 acc[2][2][4][2];
#pragma unroll
    for (int a = 0; a < 2; ++a)
#pragma unroll
        for (int b = 0; b < 2; ++b)
#pragma unroll
            for (int m = 0; m < 4; ++m)
#pragma unroll
                for (int n = 0; n < 2; ++n) acc[a][b][m][n] = (f32x4){0.f, 0.f, 0.f, 0.f};
    bf16x8 At[4][2], B0[2][2], B1[2][2];
    const char* cA = PG8_BASEA(cur.z) + (size_t)cur.pm * tstepA; const char* cB = PG8_BASEB(cur.z) + (size_t)cur.pn * tstepB;
    PG8_STAGE(PG8_SB(0, 0), cB, voffB); PG8_STAGE(PG8_SA(0, 0), cA, voffA); PG8_STAGE(PG8_SB(0, 1), cB + hstepB, voffB); PG8_STAGE(PG8_SA(0, 1), cA + hstepA, voffA);
    if (wr == 1) PG8_BAR;
    PG8_WAIT_V(4); PG8_BAR;
    PG8_STAGE(PG8_SB(1, 0), cB + kstep, voffB); PG8_STAGE(PG8_SA(1, 0), cA + kstep, voffA); PG8_STAGE(PG8_SB(1, 1), cB + hstepB + kstep, voffB);
    PG8_WAIT_V(6); PG8_BAR;
    for (;;) {
        const bool has_next = S.next(ui + 1, nxt);
        const char* nA = has_next ? PG8_BASEA(nxt.z) + (size_t)nxt.pm * tstepA : cA; const char* nB = has_next ? PG8_BASEB(nxt.z) + (size_t)nxt.pn * tstepB : cB;
        for (int t = 0; t < nt; t += 2) {
            const bool last = (t == nt - 2);
            const char* a1 = cA + (size_t)(t + 1) * kstep;
            const char* a2 = last ? nA : cA + (size_t)(t + 2) * kstep; const char* b2 = last ? nB : cB + (size_t)(t + 2) * kstep;
            const char* a3 = a2 + kstep; const char* b3 = b2 + kstep;
            PG8_LDB(B0, 0, 0); PG8_SCHED; PG8_LDA(At, 0, 0); PG8_STAGE(PG8_SA(1, 1), a1 + hstepA, voffA);
            PG8_WAIT_L(8); PG8_BAR; PG8_WAIT_L(0); PG8_MMA(0, 0, At, B0); PG8_BAR; PG8_SCHED;
            PG8_LDB(B1, 0, 1); PG8_STAGE(PG8_SB(0, 0), b2, voffB);
            PG8_BAR; PG8_WAIT_L(0); PG8_MMA(0, 1, At, B1); PG8_BAR;
            PG8_LDA(At, 0, 1); PG8_STAGE(PG8_SA(0, 0), a2, voffA);
            PG8_BAR; PG8_WAIT_L(0); PG8_MMA(1, 0, At, B0); PG8_BAR; PG8_SCHED;
            PG8_STAGE(PG8_SB(0, 1), b2 + hstepB, voffB);
            PG8_WAIT_V(6); PG8_BAR; PG8_MMA(1, 1, At, B1); PG8_BAR;
            PG8_LDB(B0, 1, 0); PG8_SCHED; PG8_LDA(At, 1, 0); PG8_STAGE(PG8_SA(0, 1), a2 + hstepA, voffA);
            PG8_WAIT_L(8); PG8_BAR; PG8_WAIT_L(0); PG8_MMA(0, 0, At, B0); PG8_BAR; PG8_SCHED;
            PG8_LDB(B1, 1, 1); PG8_STAGE(PG8_SB(1, 0), b3, voffB);
            PG8_BAR; PG8_WAIT_L(0); PG8_MMA(0, 1, At, B1); PG8_BAR;
            PG8_LDA(At, 1, 1); PG8_STAGE(PG8_SA(1, 0), a3, voffA);
            PG8_BAR; PG8_WAIT_L(0); PG8_MMA(1, 0, At, B0); PG8_BAR; PG8_SCHED;
            PG8_STAGE(PG8_SB(1, 1), b3 + hstepB, voffB);
            PG8_WAIT_V(6); PG8_BAR; PG8_MMA(1, 1, At, B1); PG8_BAR;
        }
        E(acc, cur, wr, wc, fr, fq);
        if (!has_next) break;
        if (nxt.z == 0) {
#pragma unroll
            for (int a = 0; a < 2; ++a)
#pragma unroll
                for (int b = 0; b < 2; ++b)
#pragma unroll
                    for (int m = 0; m < 4; ++m)
#pragma unroll
                        for (int n = 0; n < 2; ++n) acc[a][b][m][n] = (f32x4){0.f, 0.f, 0.f, 0.f};
        }
        cur = nxt; cA = nA; cB = nB; ++ui;
    }
    PG8_WAIT_V(0);
    if (wr == 0) PG8_BAR;
    PG8_BAR;
#undef PG8_SA
#undef PG8_SB
#undef PG8_STAGE
#undef PG8_LDA
#undef PG8_LDB
#undef PG8_MMA
#undef PG8_WAIT_V
#undef PG8_WAIT_L
#undef PG8_BAR
#undef PG8_SCHED
#undef PG8_BASEA
#undef PG8_BASEB
}
}
using pg8::Unit;
typedef f32x4 AccT[2][2][4][2];

struct EpiInProj {
    static constexpr bool PERM = true;
    bf16_t* O; const float* rot;
    __device__ __forceinline__ void operator()(const AccT& acc, const Unit& u, int wr, int wc, int fr, int fq) const {
        const int pn = u.pn;
        int mode;
        if (pn < 4) mode = 0; else if (pn < 6) mode = 1; else if (pn < 12) mode = 0; else if (pn < 16) mode = 2; else if (pn < 20) mode = 4; else if (pn < 24) mode = 5;
        else if (pn < 28) mode = 0; else if (pn < 32) mode = 2; else if (pn < 56) mode = 3; else mode = 0;
        const float SC = 0.08838834764831845f;
#pragma unroll
        for (int ai = 0; ai < 2; ++ai)
#pragma unroll
            for (int m = 0; m < 4; ++m) {
                const int row = u.pm * 256 + ai * 128 + wr * 64 + m * 16 + fr;
                bf16_t* rowp = O + (size_t)row * NIN + pn * 256 + wc * 32 + 8 * fq;
                f32x4 r0 = (f32x4){1.f, 0.f, 1.f, 0.f}, r1 = r0;
                if (mode >= 4) { const int pidx = row < NPROMPT ? (row & (SEQ - 1)) : SEQ; const f32x4* rp = (const f32x4*)(rot + ((size_t)pidx * 64 + 16 * wc + 4 * fq) * 2); r0 = rp[0]; r1 = rp[1]; }
#pragma unroll
                for (int bj = 0; bj < 2; ++bj) {
                    f32x4 v0 = acc[ai][bj][m][0], v1 = acc[ai][bj][m][1];
                    if (mode >= 4) {
                        f32x4 a, b;
                        a[0] = v0[0] * r0[0] - v0[1] * r0[1]; a[1] = v0[1] * r0[0] + v0[0] * r0[1];
                        a[2] = v0[2] * r0[2] - v0[3] * r0[3]; a[3] = v0[3] * r0[2] + v0[2] * r0[3];
                        b[0] = v1[0] * r1[0] - v1[1] * r1[1]; b[1] = v1[1] * r1[0] + v1[0] * r1[1];
                        b[2] = v1[2] * r1[2] - v1[3] * r1[3]; b[3] = v1[3] * r1[2] + v1[2] * r1[3];
                        v0 = a; v1 = b;
                        if (mode == 5) { v0 *= SC; v1 *= SC; }
                    } else if (mode == 1) { v0 *= SC; v1 *= SC; }
                    else if (mode == 2) {
#pragma unroll
                        for (int j = 0; j < 4; ++j) { v0[j] = siluf_(v0[j]); v1[j] = siluf_(v1[j]); } }
                    else if (mode == 3) {
#pragma unroll
                        for (int j = 0; j < 4; ++j) { v0[j] = sigmoidf_(v0[j]); v1[j] = sigmoidf_(v1[j]); } }
                    u32x4 w; w.x = cvt_pk_bf16(v0[0], v0[1]); w.y = cvt_pk_bf16(v0[2], v0[3]); w.z = cvt_pk_bf16(v1[0], v1[1]); w.w = cvt_pk_bf16(v1[2], v1[3]);
                    *(u32x4*)(rowp + bj * 128) = w;
                }
            }
    }
};
struct EpiGlu {
    static constexpr bool PERM = true;
    bf16_t* O; const bf16_t* Y; const float* bias;
    __device__ __forceinline__ void operator()(const AccT& acc, const Unit& u, int wr, int wc, int fr, int fq) const {
#pragma unroll
        for (int bj = 0; bj < 2; ++bj) {
            const int col = u.pn * 256 + bj * 128 + wc * 32 + 8 * fq;
            const f32x4 b0 = *(const f32x4*)(bias + col), b1 = *(const f32x4*)(bias + col + 4);
#pragma unroll
            for (int ai = 0; ai < 2; ++ai)
#pragma unroll
                for (int m = 0; m < 4; ++m) {
                    const int row = u.pm * 256 + ai * 128 + wr * 64 + m * 16 + fr;
                    const u32x4 y = *(const u32x4*)(Y + (size_t)row * 1024 + col);
                    const f32x4 v0 = acc[ai][bj][m][0] + b0, v1 = acc[ai][bj][m][1] + b1;
                    u32x4 w;
                    w.x = cvt_pk_bf16(bflo(y.x) * sigmoidf_(v0[0]), bfhi(y.x) * sigmoidf_(v0[1]));
                    w.y = cvt_pk_bf16(bflo(y.y) * sigmoidf_(v0[2]), bfhi(y.y) * sigmoidf_(v0[3]));
                    w.z = cvt_pk_bf16(bflo(y.z) * sigmoidf_(v1[0]), bfhi(y.z) * sigmoidf_(v1[1]));
                    w.w = cvt_pk_bf16(bflo(y.w) * sigmoidf_(v1[2]), bfhi(y.w) * sigmoidf_(v1[3]));
                    *(u32x4*)(O + (size_t)row * 1024 + col) = w;
                }
        }
    }
};
struct EpiMerge {
    static constexpr bool PERM = false;
    bf16_t* O; const bf16_t* proj;
    __device__ __forceinline__ void operator()(AccT& acc, const Unit& u, int wr, int wc, int fr, int fq) const {
        const int z = u.z;
#pragma unroll
        for (int ai = 0; ai < 2; ++ai)
#pragma unroll
            for (int m = 0; m < 4; ++m) {
                const int row = u.pm * 256 + ai * 128 + wr * 64 + m * 16 + fr;
#pragma unroll
                for (int bj = 0; bj < 2; ++bj)
#pragma unroll
                    for (int n = 0; n < 2; ++n) {
                        const int col = u.pn * 256 + bj * 128 + wc * 32 + n * 16 + 4 * fq;
                        const bf16_t* gp = proj + (size_t)row * NIN + OFF_MG + z * 2048 + col;
                        const u32x2 ga = *(const u32x2*)gp;
                        f32x4 v = acc[ai][bj][m][n];
                        v[0] *= bflo(ga.x); v[1] *= bfhi(ga.x); v[2] *= bflo(ga.y); v[3] *= bfhi(ga.y);
                        if ((DBG_ZMASK >> z) & 1) v = (f32x4){0.f, 0.f, 0.f, 0.f};
                        if (z < 2) {
                            const u32x2 gb = *(const u32x2*)(gp + 2048);
                            v[0] *= __builtin_amdgcn_rcpf(fmaxf(bflo(gb.x), 1e-30f)); v[1] *= __builtin_amdgcn_rcpf(fmaxf(bfhi(gb.x), 1e-30f));
                            v[2] *= __builtin_amdgcn_rcpf(fmaxf(bflo(gb.y), 1e-30f)); v[3] *= __builtin_amdgcn_rcpf(fmaxf(bfhi(gb.y), 1e-30f));
                            acc[ai][bj][m][n] = v;
                        } else { u32x2 w; w.x = cvt_pk_bf16(v[0], v[1]); w.y = cvt_pk_bf16(v[2], v[3]); *(u32x2*)(O + (size_t)row * DM + col) = w; }
                    }
            }
    }
};
struct EpiResid {
    static constexpr bool PERM = false;
    float* O; XSrc res; int zero;
    __device__ __forceinline__ void operator()(const AccT& acc, const Unit& u, int wr, int wc, int fr, int fq) const {
#pragma unroll
        for (int ai = 0; ai < 2; ++ai)
#pragma unroll
            for (int m = 0; m < 4; ++m) {
                const int row = u.pm * 256 + ai * 128 + wr * 64 + m * 16 + fr;
                const bool ok = row < res.valid;
                const float* rp = res.row(ok ? row : 0);
#pragma unroll
                for (int bj = 0; bj < 2; ++bj)
#pragma unroll
                    for (int n = 0; n < 2; ++n) {
                        const int col = u.pn * 256 + bj * 128 + wc * 32 + n * 16 + 4 * fq;
                        f32x4 v = acc[ai][bj][m][n];
                        if (zero) v = (f32x4){0.f, 0.f, 0.f, 0.f};
                        if (ok) v += *(const f32x4*)(rp + col);
                        *(f32x4*)(O + (size_t)row * DM + col) = v;
                    }
            }
    }
};
struct EpiFfnUp {
    static constexpr bool PERM = true;
    bf16_t* O;
    __device__ __forceinline__ void operator()(const AccT& acc, const Unit& u, int wr, int wc, int fr, int fq) const {
#pragma unroll
        for (int ai = 0; ai < 2; ++ai)
#pragma unroll
            for (int m = 0; m < 4; ++m) {
                const int row = u.pm * 256 + ai * 128 + wr * 64 + m * 16 + fr;
                const f32x4 g0 = acc[ai][0][m][0], g1 = acc[ai][0][m][1], u0 = acc[ai][1][m][0], u1 = acc[ai][1][m][1];
                u32x4 w;
                w.x = cvt_pk_bf16(siluf_(g0[0]) * u0[0], siluf_(g0[1]) * u0[1]); w.y = cvt_pk_bf16(siluf_(g0[2]) * u0[2], siluf_(g0[3]) * u0[3]);
                w.z = cvt_pk_bf16(siluf_(g1[0]) * u1[0], siluf_(g1[1]) * u1[1]); w.w = cvt_pk_bf16(siluf_(g1[2]) * u1[2], siluf_(g1[3]) * u1[3]);
                *(u32x4*)(O + (size_t)row * DFF + u.pn * 128 + wc * 32 + 8 * fq) = w;
            }
    }
};

struct ConvTile { const float* src; bf16_t* dst; int ldw, ldt, valid; };
__device__ __forceinline__ ConvTile conv_decode(ParamsK p, int id) {
    const int PER_LAYER = 18560;
    ConvTile c; c.valid = 64;
    const int l = id / PER_LAYER; int t = id - l * PER_LAYER;
    if (t < 7296) { const int tk = t / 228, tn = t % 228, n0 = tn * 64; int sc;
        if (n0 < 4096) sc = n0; else if (n0 < 14336) sc = n0 + 16; else if (n0 == 14336) { sc = 4096; c.valid = 16; } else { sc = 0; c.valid = 0; }
        c.ldw = WIN_SRC; c.src = p->in[7] + (size_t)l * 2048 * WIN_SRC + (size_t)(tk * 64) * c.ldw + sc; c.ldt = 2048; c.dst = (bf16_t*)(p->ws + WS_WIN + l * SZ_WIN) + (size_t)n0 * c.ldt + tk * 64; }
    else if (t < 7552) { t -= 7296; const int tk = t / 16, tn = t % 16; c.ldw = 1024; c.src = p->in[16] + (size_t)l * 1024 * 1024 + (size_t)(tk * 64) * c.ldw + tn * 64; c.ldt = 1024; c.dst = (bf16_t*)(p->ws + WS_WGLU + l * SZ_WGLU) + (size_t)(tn * 64) * c.ldt + tk * 64; }
    else if (t < 9088) { t -= 7552; const int which = t / 512; t -= which * 512; const int tk = t / 32, tn = t % 32; c.ldw = 2048;
        const float* base = which == 0 ? p->in[18] : (which == 1 ? p->in[22] : p->in[23]);
        const size_t wo = which == 0 ? WS_WS5O : (which == 1 ? WS_WGLAO : WS_WRETO);
        c.src = base + (size_t)l * 1024 * 2048 + (size_t)(tk * 64) * c.ldw + tn * 64; c.ldt = 1024; c.dst = (bf16_t*)(p->ws + wo + l * SZ_WBR) + (size_t)(tn * 64) * c.ldt + tk * 64; }
    else if (t < 10112) { t -= 9088; const int tk = t / 32, tn = t % 32; c.ldw = 2048; c.src = p->in[24] + (size_t)l * 2048 * 2048 + (size_t)(tk * 64) * c.ldw + tn * 64; c.ldt = 2048; c.dst = (bf16_t*)(p->ws + WS_WMIX + l * SZ_WMIX) + (size_t)(tn * 64) * c.ldt + tk * 64; }
    else if (t < 15744) { t -= 10112; const int tk = t / 176, tn = t % 176, n0 = tn * 64, pn = n0 >> 8, within = n0 & 255; const bool isup = within >= 128; const int ff0 = pn * 128 + (within & 127);
        c.ldw = DFF; c.src = (isup ? p->in[27] : p->in[26]) + (size_t)l * 2048 * DFF + (size_t)(tk * 64) * c.ldw + ff0; c.ldt = 2048; c.dst = (bf16_t*)(p->ws + WS_WGU + l * SZ_WGU) + (size_t)n0 * c.ldt + tk * 64; }
    else { t -= 15744; const int tk = t / 32, tn = t % 32; c.ldw = 2048; c.src = p->in[28] + (size_t)l * DFF * 2048 + (size_t)(tk * 64) * c.ldw + tn * 64; c.ldt = DFF; c.dst = (bf16_t*)(p->ws + WS_WDN + l * SZ_WDN) + (size_t)(tn * 64) * c.ldt + tk * 64; }
    return c;
}
__device__ __forceinline__ void conv_weights(ParamsK p, LAS float* T) {
    const int tid = fresh_tid();
    const int kk = tid >> 4, n4 = (tid & 15) * 4;
    const int n = tid >> 3, k8 = (tid & 7) * 8;
    const int TOTAL = 2 * 18560;
    const int stride = gridDim.x * 4;
    f32x4 v[4][2];
#define CONV_LOAD(ID0) do { _Pragma("unroll") for (int u = 0; u < 4; ++u) { const ConvTile c = conv_decode(p, (ID0) + u); \
        _Pragma("unroll") for (int ps = 0; ps < 2; ++ps) { v[u][ps] = (f32x4){0.f, 0.f, 0.f, 0.f}; if (n4 < c.valid) v[u][ps] = __builtin_nontemporal_load((const f32x4*)(c.src + (size_t)(kk + 32 * ps) * c.ldw + n4)); } } } while (0)
    int id0 = fresh_bid() * 4;
    if (id0 < TOTAL) CONV_LOAD(id0);
    for (; id0 < TOTAL; id0 += stride) {
        bf16_t* dstp[4];
#pragma unroll
        for (int u = 0; u < 4; ++u) { const ConvTile c = conv_decode(p, id0 + u); dstp[u] = c.dst + (size_t)n * c.ldt + k8; }
#pragma unroll
        for (int u = 0; u < 4; ++u)
#pragma unroll
            for (int ps = 0; ps < 2; ++ps) { LAS float* tp = T + u * 4160 + (kk + 32 * ps) * 65 + n4; tp[0] = v[u][ps][0]; tp[1] = v[u][ps][1]; tp[2] = v[u][ps][2]; tp[3] = v[u][ps][3]; }
        if (id0 + stride < TOTAL) CONV_LOAD(id0 + stride);
        __syncthreads();
#pragma unroll
        for (int u = 0; u < 4; ++u) {
            const LAS float* tp = T + u * 4160 + k8 * 65 + n;
            u32x4 w;
            w.x = cvt_pk_bf16(tp[0 * 65], tp[1 * 65]); w.y = cvt_pk_bf16(tp[2 * 65], tp[3 * 65]); w.z = cvt_pk_bf16(tp[4 * 65], tp[5 * 65]); w.w = cvt_pk_bf16(tp[6 * 65], tp[7 * 65]);
            *(u32x4*)dstp[u] = w;
        }
        __syncthreads();
    }
#undef CONV_LOAD
}

__device__ __forceinline__ void sincos_d(double a, double& s, double& c) {
    const double qd = rint(a * 0.63661977236758134);
    double rr = fma(-qd, 1.5707963267948966, a); rr = fma(-qd, 6.123233995736766e-17, rr);
    const int qi = ((int)qd) & 3;
    const double x2 = rr * rr;
    const double sp = rr * (1.0 + x2 * (-1.0 / 6 + x2 * (1.0 / 120 + x2 * (-1.0 / 5040 + x2 * (1.0 / 362880 + x2 * (-1.0 / 39916800 + x2 * (1.0 / 6227020800.0 + x2 * (-1.0 / 1307674368000.0))))))));
    const double cp = 1.0 + x2 * (-0.5 + x2 * (1.0 / 24 + x2 * (-1.0 / 720 + x2 * (1.0 / 40320 + x2 * (-1.0 / 3628800 + x2 * (1.0 / 479001600.0 + x2 * (-1.0 / 87178291200.0 + x2 * (1.0 / 20922789888000.0))))))));
    if (qi == 0) { s = sp; c = cp; } else if (qi == 1) { s = cp; c = -sp; } else if (qi == 2) { s = -sp; c = -cp; } else { s = -cp; c = sp; }
}

__device__ __forceinline__ void norm_rows(const XSrc src, const float* gain, bf16_t* dbf, float* df32) {
    const int lane = fresh_tid() & 63, gw = fresh_bid() * 8 + (fresh_tid() >> 6), nw = gridDim.x * 8;
    for (int row = gw; row < MROWS; row += 2 * nw) {
        const int row2 = row + nw < MROWS ? row + nw : row;
        const float* xp = src.row(row); const float* xq = src.row(row2);
        f32x4 v[8], u[8]; float ss = 0.f, st = 0.f;
#pragma unroll
        for (int i = 0; i < 8; ++i) { v[i] = *(const f32x4*)(xp + i * 256 + lane * 4); u[i] = *(const f32x4*)(xq + i * 256 + lane * 4); }
#pragma unroll
        for (int i = 0; i < 8; ++i) { ss += v[i][0] * v[i][0] + v[i][1] * v[i][1] + v[i][2] * v[i][2] + v[i][3] * v[i][3]; st += u[i][0] * u[i][0] + u[i][1] * u[i][1] + u[i][2] * u[i][2] + u[i][3] * u[i][3]; }
#pragma unroll
        for (int o = 32; o > 0; o >>= 1) { ss += __shfl_xor(ss, o); st += __shfl_xor(st, o); }
        const float rs = 1.0f / sqrtf(ss * (1.0f / DM) + 1e-6f), rt = 1.0f / sqrtf(st * (1.0f / DM) + 1e-6f);
#pragma unroll
        for (int i = 0; i < 8; ++i) {
            const f32x4 gn = *(const f32x4*)(gain + i * 256 + lane * 4);
            const f32x4 y = v[i] * rs * gn, y2 = u[i] * rt * gn;
            if (dbf) { u32x2 w; w.x = cvt_pk_bf16(y[0], y[1]); w.y = cvt_pk_bf16(y[2], y[3]); *(u32x2*)(dbf + (size_t)row * DM + i * 256 + lane * 4) = w;
                       if (row2 != row) { w.x = cvt_pk_bf16(y2[0], y2[1]); w.y = cvt_pk_bf16(y2[2], y2[3]); *(u32x2*)(dbf + (size_t)row2 * DM + i * 256 + lane * 4) = w; } }
            if (df32) { *(f32x4*)(df32 + (size_t)row * DM + i * 256 + lane * 4) = y; if (row2 != row) *(f32x4*)(df32 + (size_t)row2 * DM + i * 256 + lane * 4) = y2; }
        }
    }
}

__device__ __forceinline__ void phase_prepass(ParamsK p, LAS unsigned char* lds) {
    conv_weights(p, (LAS float*)lds);
    const int gt = fresh_bid() * 512 + fresh_tid(), ngt = gridDim.x * 512;
    for (int i = gt; i < 2049 * 64; i += ngt) {
        const int pidx = i >> 6, fi = i & 63;
        const double inv = exp(-((double)fi / 63.0) * 9.210340371976184);
        const double pos = pidx < SEQ ? (double)pidx : 16384.0;
        double s, c; sincos_d(pos * inv, s, c);
        ((f32x2*)(p->ws + WS_ROT))[i] = (f32x2){(float)c, (float)s};
    }
    for (int i = gt; i < 2 * 64 * 64; i += ngt) {
        const int l = i >> 12, g = (i >> 6) & 63, pp = i & 63;
        const double dt = exp((double)p->in[10][l * 64 + g]);
        const double ar = p->in[8][i], ai = p->in[9][i];
        const double mag = exp(ar * dt); double s, c; sincos_d(ai * dt, s, c);
        const double abr = mag * c, abi = mag * s, den = ar * ar + ai * ai, nr = abr - 1.0, ni = abi;
        const double fr = (nr * ar + ni * ai) / den, fi = (ni * ar - nr * ai) / den;
        double zr = abr, zi = abi;
#pragma unroll 1
        for (int k = 0; k < 6; ++k) { const double t = zr * zr - zi * zi; zi = 2.0 * zr * zi; zr = t; }
        ((f32x4*)(p->ws + WS_S5A))[i] = (f32x4){(float)abr, (float)abi, (float)zr, (float)zi};
        const float* br = p->in[11] + (size_t)i * 16; const float* bi = p->in[12] + (size_t)i * 16;
        f32x2* bo = (f32x2*)(p->ws + WS_S5B) + (size_t)i * 16;
        bf16_t* bmt = (bf16_t*)(p->ws + WS_S5BM) + (size_t)(l * 64 + g) * 2 * 128 * 16;
#pragma unroll 1
        for (int n = 0; n < 16; ++n) { const double b_r = br[n], b_i = bi[n]; const float vr = (float)(fr * b_r - fi * b_i), vi = (float)(fr * b_i + fi * b_r);
            bo[n] = (f32x2){vr, vi}; const bf16_t hr = f2bf(vr), hi = f2bf(vi);
            bmt[pp * 16 + n] = hr; bmt[(64 + pp) * 16 + n] = hi; bmt[2048 + pp * 16 + n] = f2bf(vr - bf2f(hr)); bmt[2048 + (64 + pp) * 16 + n] = f2bf(vi - bf2f(hi)); }
        bf16_t* cm = (bf16_t*)(p->ws + WS_S5C) + (size_t)(l * 64 + g) * 16 * 128;
        const float* cr = p->in[13] + (size_t)(l * 64 + g) * 16 * 64; const float* ci = p->in[14] + (size_t)(l * 64 + g) * 16 * 64;
#pragma unroll 1
        for (int n = 0; n < 16; ++n) { cm[n * 128 + pp] = f2bf(cr[n * 64 + pp]); cm[n * 128 + 64 + pp] = f2bf(-ci[n * 64 + pp]); }
    }
    XSrc x0; x0.a = p->in[0]; x0.b = p->in[1]; x0.split = NPROMPT; x0.valid = MROWS;
    norm_rows(x0, p->in[6], (bf16_t*)(p->ws + WS_XN), nullptr);
}

__device__ __forceinline__ f32x4 mma_lds(f32x4 acc, const LAS bf16_t* A, int lda, const LAS bf16_t* B, int ldb, int K, int lane) {
    const int r = lane & 15, q = lane >> 4;
    const LAS bf16_t* ap = A + r * lda + q * 8; const LAS bf16_t* bp = B + r * ldb + q * 8;
    for (int k = 0; k < K; k += 32) {
        const bf16x8 a = *(const LAS bf16x8*)(ap + k), b = *(const LAS bf16x8*)(bp + k);
        acc = __builtin_amdgcn_mfma_f32_16x16x32_bf16(a, b, acc, 0, 0, 0);
    }
    return acc;
}


__device__ __forceinline__ void phase_gates(ParamsK p, int l) {
    const bf16_t* proj = (const bf16_t*)(p->ws + WS_PROJ);
    float* bcum = (float*)(p->ws + WS_BCUM);
    for (int idx = fresh_bid() * 512 + fresh_tid(); idx < 128 * 512; idx += gridDim.x * 512) {
        const int c = idx >> 9, hk = idx & 511;
        float wg[16];
#pragma unroll
        for (int rr = 0; rr < 16; ++rr) wg[rr] = p->in[19][((size_t)l * 16 + rr) * 512 + hk];
        const float bias = p->in[20][l * 512 + hk];
        float cum = 0.f;
#pragma unroll 4
        for (int t = 0; t < 64; ++t) {
            const size_t row = (size_t)c * 64 + t;
            const u32x4 g0 = *(const u32x4*)(proj + row * NIN + OFF_GLR), g1 = *(const u32x4*)(proj + row * NIN + OFF_GLR + 8);
            float lo = bias;
            lo += bflo(g0.x) * wg[0] + bfhi(g0.x) * wg[1] + bflo(g0.y) * wg[2] + bfhi(g0.y) * wg[3] + bflo(g0.z) * wg[4] + bfhi(g0.z) * wg[5] + bflo(g0.w) * wg[6] + bfhi(g0.w) * wg[7];
            lo += bflo(g1.x) * wg[8] + bfhi(g1.x) * wg[9] + bflo(g1.y) * wg[10] + bfhi(g1.y) * wg[11] + bflo(g1.z) * wg[12] + bfhi(g1.z) * wg[13] + bflo(g1.w) * wg[14] + bfhi(g1.w) * wg[15];
            cum += logsigmoidf_(lo) * 0.0625f;
            bcum[row * 512 + hk] = cum;
        }
    }
}

template <bool RET>
__device__ __forceinline__ void recur_item(ParamsK p, int l, int b, int h, int vs, LAS unsigned char* lds) {
    constexpr int DV = RET ? 128 : 256, NH = RET ? 8 : 4;
    const int tid = fresh_tid(), w = tid >> 6, lane = tid & 63, r = lane & 15, q = lane >> 4;
    LAS float* Bc = (LAS float*)lds;
    LAS bf16_t* Qt = (LAS bf16_t*)(lds + 32768);
    LAS bf16_t* Kt = Qt + 64 * 136;
    LAS bf16_t* KhT = Kt + 64 * 136;
    LAS bf16_t* Vt = KhT + 128 * 72;
    LAS bf16_t* Pm = Vt + 64 * 72;
    LAS bf16_t* St = Pm + 64 * 72;
    LAS float* Gl = (LAS float*)(St + 64 * 136);
    LAS float* Gs = Gl + 64 * 16;
    const bf16_t* proj = (const bf16_t*)(p->ws + WS_PROJ);
    float* oraw = (float*)(p->ws + WS_ORAW);
    const int qcol = (RET ? OFF_RQ : OFF_GQ) + h * 128, kcol = (RET ? OFF_RK : OFF_GK) + h * 128, vcol = (RET ? OFF_RV : OFF_GV) + h * DV + vs * 64;
    const int ocol = (RET ? 1024 + h * 128 : h * 256) + vs * 64;
    for (int i = tid; i < 64 * 136; i += 512) St[i] = 0;
    const float* bcum = (const float*)(p->ws + WS_BCUM) + h * 128;
    const float lg = log1pf(-exp2f(-5.0f - (float)h));
    (void)Bc;
    f32x4 accS[4];
#pragma unroll
    for (int i = 0; i < 4; ++i) accS[i] = (f32x4){0.f, 0.f, 0.f, 0.f};
    u32x4 nq[2], nk[2], nv; f32x4 nb[2][2], nl[2], nd;
    {
        const size_t row0 = (size_t)b * SEQ;
#pragma unroll
        for (int i = 0; i < 2; ++i) { const int idx = tid + i * 512, t = idx >> 4, kv = (idx & 15) * 8;
            nq[i] = *(const u32x4*)(proj + (row0 + t) * NIN + qcol + kv); nk[i] = *(const u32x4*)(proj + (row0 + t) * NIN + kcol + kv); }
        nv = *(const u32x4*)(proj + (row0 + (tid >> 3)) * NIN + vcol + (tid & 7) * 8);
        if (!RET) {
#pragma unroll
            for (int i = 0; i < 2; ++i) { const int idx = tid + i * 512, t = idx >> 4, kv = (idx & 15) * 8; nb[i][0] = *(const f32x4*)(bcum + (row0 + t) * 512 + kv); nb[i][1] = *(const f32x4*)(bcum + (row0 + t) * 512 + kv + 4); }
            { const int kv = (tid & 15) * 8; nl[0] = *(const f32x4*)(bcum + (row0 + 63) * 512 + kv); nl[1] = *(const f32x4*)(bcum + (row0 + 63) * 512 + kv + 4); nd = *(const f32x4*)(bcum + (row0 + 63) * 512 + 16 * w + q * 4); } }
    }
    __syncthreads();
    for (int c = 0; c < 32; ++c) {
        const size_t row0 = (size_t)b * SEQ + c * 64;
#pragma unroll
        for (int i = 0; i < 2; ++i) {
            const int idx = tid + i * 512, t = idx >> 4, kv = (idx & 15) * 8;
            float bb[8], bl[8];
            if (RET) {
#pragma unroll
                for (int j = 0; j < 8; ++j) { bb[j] = (float)(t + 1) * lg; bl[j] = 64.0f * lg; }
            } else {
                const f32x4 b0 = nb[i][0], b1 = nb[i][1], l0 = nl[0], l1 = nl[1];
                bb[0] = b0[0]; bb[1] = b0[1]; bb[2] = b0[2]; bb[3] = b0[3]; bb[4] = b1[0]; bb[5] = b1[1]; bb[6] = b1[2]; bb[7] = b1[3];
                bl[0] = l0[0]; bl[1] = l0[1]; bl[2] = l0[2]; bl[3] = l0[3]; bl[4] = l1[0]; bl[5] = l1[1]; bl[6] = l1[2]; bl[7] = l1[3];
            }
            float qf[8] = {bflo(nq[i].x), bfhi(nq[i].x), bflo(nq[i].y), bfhi(nq[i].y), bflo(nq[i].z), bfhi(nq[i].z), bflo(nq[i].w), bfhi(nq[i].w)};
            float kf[8] = {bflo(nk[i].x), bfhi(nk[i].x), bflo(nk[i].y), bfhi(nk[i].y), bflo(nk[i].z), bfhi(nk[i].z), bflo(nk[i].w), bfhi(nk[i].w)};
            float qt[8], kt[8];
#pragma unroll
            for (int j = 0; j < 8; ++j) { const float em = __expf(-bb[j]); qt[j] = qf[j] * __expf(bb[j]); kt[j] = kf[j] * em; KhT[(kv + j) * 72 + (t ^ (((kv >> 3) & 7) << 3))] = f2bf(kt[j] * __expf(bl[j])); }
            u32x4 wq, wk;
            wq.x = cvt_pk_bf16(qt[0], qt[1]); wq.y = cvt_pk_bf16(qt[2], qt[3]); wq.z = cvt_pk_bf16(qt[4], qt[5]); wq.w = cvt_pk_bf16(qt[6], qt[7]);
            wk.x = cvt_pk_bf16(kt[0], kt[1]); wk.y = cvt_pk_bf16(kt[2], kt[3]); wk.z = cvt_pk_bf16(kt[4], kt[5]); wk.w = cvt_pk_bf16(kt[6], kt[7]);
            *(LAS u32x4*)(Qt + t * 136 + kv) = wq; *(LAS u32x4*)(Kt + t * 136 + kv) = wk;
        }
        { const int t = tid >> 3, vv = (tid & 7) * 8; LAS bf16_t* vp = Vt + vv * 72 + (t ^ (((vv >> 3) & 7) << 3));
            vp[0 * 72] = (bf16_t)(nv.x & 0xffffu); vp[1 * 72] = (bf16_t)(nv.x >> 16); vp[2 * 72] = (bf16_t)(nv.y & 0xffffu); vp[3 * 72] = (bf16_t)(nv.y >> 16);
            vp[4 * 72] = (bf16_t)(nv.z & 0xffffu); vp[5 * 72] = (bf16_t)(nv.z >> 16); vp[6 * 72] = (bf16_t)(nv.w & 0xffffu); vp[7 * 72] = (bf16_t)(nv.w >> 16); }
        const f32x4 dec = RET ? (f32x4){__expf(64.0f * lg), __expf(64.0f * lg), __expf(64.0f * lg), __expf(64.0f * lg)} : (f32x4){__expf(nd[0]), __expf(nd[1]), __expf(nd[2]), __expf(nd[3])};
        if (c + 1 < 32) {
            const size_t rn = row0 + 64;
#pragma unroll
            for (int i = 0; i < 2; ++i) { const int idx = tid + i * 512, t = idx >> 4, kv = (idx & 15) * 8;
                nq[i] = *(const u32x4*)(proj + (rn + t) * NIN + qcol + kv); nk[i] = *(const u32x4*)(proj + (rn + t) * NIN + kcol + kv); }
            nv = *(const u32x4*)(proj + (rn + (tid >> 3)) * NIN + vcol + (tid & 7) * 8);
            if (!RET) {
#pragma unroll
                for (int i = 0; i < 2; ++i) { const int idx = tid + i * 512, t = idx >> 4, kv = (idx & 15) * 8; nb[i][0] = *(const f32x4*)(bcum + (rn + t) * 512 + kv); nb[i][1] = *(const f32x4*)(bcum + (rn + t) * 512 + kv + 4); }
                { const int kv = (tid & 15) * 8; nl[0] = *(const f32x4*)(bcum + (rn + 63) * 512 + kv); nl[1] = *(const f32x4*)(bcum + (rn + 63) * 512 + kv + 4); nd = *(const f32x4*)(bcum + (rn + 63) * 512 + 16 * w + q * 4); } }
        }
        __syncthreads();
        const int tm = w >> 1, vb = w & 1;
#pragma unroll
        for (int s2 = 0; s2 < 2; ++s2) {
            const int sn = (w & 1) * 2 + s2;
            f32x4 sc = mma_lds((f32x4){0.f, 0.f, 0.f, 0.f}, Qt + tm * 16 * 136, 136, Kt + sn * 16 * 136, 136, 128, lane);
#pragma unroll
            for (int j = 0; j < 4; ++j) if (sn > tm || (sn == tm && r > q * 4 + j)) sc[j] = 0.f;
#pragma unroll
            for (int j = 0; j < 4; ++j) Pm[(tm * 16 + q * 4 + j) * 72 + sn * 16 + r] = f2bf(sc[j]);
        }
        f32x4 acco[2];
#pragma unroll
        for (int u = 0; u < 2; ++u) acco[u] = mma_lds((f32x4){0.f, 0.f, 0.f, 0.f}, Qt + tm * 16 * 136, 136, St + (vb + 2 * u) * 16 * 136, 136, 128, lane);
        __syncthreads();
#pragma unroll
        for (int u = 0; u < 2; ++u) {
            { const int vt = vb + 2 * u, swv = ((2 * vt + (r >> 3)) & 7) << 3; const LAS bf16_t* pp = Pm + (tm * 16 + r) * 72 + q * 8; const LAS bf16_t* vr = Vt + (vt * 16 + r) * 72;
              acco[u] = __builtin_amdgcn_mfma_f32_16x16x32_bf16(*(const LAS bf16x8*)pp, *(const LAS bf16x8*)(vr + ((q * 8) ^ swv)), acco[u], 0, 0, 0);
              acco[u] = __builtin_amdgcn_mfma_f32_16x16x32_bf16(*(const LAS bf16x8*)(pp + 32), *(const LAS bf16x8*)(vr + ((32 + q * 8) ^ swv)), acco[u], 0, 0, 0); }
#pragma unroll
            for (int j = 0; j < 4; ++j) oraw[(row0 + tm * 16 + q * 4 + j) * DM + ocol + (vb + 2 * u) * 16 + r] = acco[u][j];
        }
        {
            const int swk = ((2 * w + (r >> 3)) & 7) << 3;
            const bf16x8 ka0 = *(const LAS bf16x8*)(KhT + (16 * w + r) * 72 + ((q * 8) ^ swk)), ka1 = *(const LAS bf16x8*)(KhT + (16 * w + r) * 72 + ((32 + q * 8) ^ swk));
#pragma unroll
            for (int v2 = 0; v2 < 4; ++v2) {
                accS[v2] = accS[v2] * dec;
                { const int swv = ((2 * v2 + (r >> 3)) & 7) << 3; const LAS bf16_t* vr = Vt + (v2 * 16 + r) * 72;
                  accS[v2] = __builtin_amdgcn_mfma_f32_16x16x32_bf16(ka0, *(const LAS bf16x8*)(vr + ((q * 8) ^ swv)), accS[v2], 0, 0, 0);
                  accS[v2] = __builtin_amdgcn_mfma_f32_16x16x32_bf16(ka1, *(const LAS bf16x8*)(vr + ((32 + q * 8) ^ swv)), accS[v2], 0, 0, 0); }
                u32x2 ws; ws.x = cvt_pk_bf16(accS[v2][0], accS[v2][1]); ws.y = cvt_pk_bf16(accS[v2][2], accS[v2][3]);
                *(LAS u32x2*)(St + (v2 * 16 + r) * 136 + 16 * w + q * 4) = ws;
            }
        }
        __syncthreads();
    }
    float* so = p->out + (RET ? O_PRET : O_PGLA) + ((size_t)(l * NB + b) * NH + h) * 128 * DV;
#pragma unroll
    for (int v2 = 0; v2 < 4; ++v2)
#pragma unroll
        for (int j = 0; j < 4; ++j) so[(size_t)(16 * w + q * 4 + j) * DV + vs * 64 + v2 * 16 + r] = accS[v2][j];
    __syncthreads();
}

__device__ __forceinline__ void s5_prompt_item(ParamsK p, int l, int b, int g, LAS unsigned char* lds) {
    const int tid = fresh_tid(), w = tid >> 6, lane = tid & 63, r = lane & 15, q = lane >> 4;
    LAS f32x2* F = (LAS f32x2*)lds;
    LAS f32x2* Ss = F;
    LAS float* Bu = (LAS float*)(lds + 16384 + w * 12800);
    LAS bf16_t* Xw = (LAS bf16_t*)(lds + 16384 + w * 12800 + 8448);
    const bf16_t* proj = (const bf16_t*)(p->ws + WS_PROJ);
    bf16_t* y5g = (bf16_t*)(p->ws + WS_Y5G);
    const int lg = l * 64 + g;
    const f32x4 av = ((const f32x4*)(p->ws + WS_S5A))[lg * 64 + lane];
    const float abr = av[0], abi = av[1];
    bf16x8 bm[8];
    { const bf16_t* bmt = (const bf16_t*)(p->ws + WS_S5BM) + (size_t)lg * 2 * 128 * 16;
#pragma unroll
      for (int i = 0; i < 8; ++i) bm[i] = *(const bf16x8*)(bmt + (q >> 1) * 2048 + (i * 16 + r) * 16 + (q & 1) * 8); }
    const bf16_t* ubase = proj + ((size_t)b * SEQ + r) * NIN + OFF_U + g * 16 + (q & 1) * 8;
#define S5_BLOCK(c, tb) do { const bf16x8 ub = *(const bf16x8*)(ubase + (size_t)((c) * 64 + (tb) * 16) * NIN); \
        _Pragma("unroll") for (int i = 0; i < 8; ++i) { const f32x4 a4 = __builtin_amdgcn_mfma_f32_16x16x32_bf16(bm[i], ub, (f32x4){0.f, 0.f, 0.f, 0.f}, 0, 0, 0); *(LAS f32x4*)(Bu + r * 132 + i * 16 + q * 4) = a4; } \
        asm volatile("s_waitcnt lgkmcnt(0)" ::: "memory"); } while (0)
#define S5_STEP(t) do { const float bur = Bu[(t) * 132 + lane], bui = Bu[(t) * 132 + 64 + lane]; \
        const float nxr = abr * x[0] - abi * x[1] + bur, nxi = abr * x[1] + abi * x[0] + bui; x[0] = nxr; x[1] = nxi; } while (0)
    for (int ci = 0; ci < 4; ++ci) {
        const int c = w + 8 * ci;
        f32x2 x = (f32x2){0.f, 0.f};
        for (int tb = 0; tb < 4; ++tb) {
            S5_BLOCK(c, tb);
#pragma unroll
            for (int tt = 0; tt < 16; ++tt) S5_STEP(tt);
            asm volatile("s_waitcnt lgkmcnt(0)" ::: "memory");
        }
        F[c * 64 + lane] = x;
    }
    __syncthreads();
    if (w == 0) {
        const float a64r = av[2], a64i = av[3];
        f32x2 s = (f32x2){0.f, 0.f};
        for (int c = 0; c < 32; ++c) { const f32x2 f = F[c * 64 + lane]; Ss[c * 64 + lane] = s;
            const float nr = a64r * s[0] - a64i * s[1] + f[0], ni = a64r * s[1] + a64i * s[0] + f[1]; s[0] = nr; s[1] = ni; }
        p->out[O_PS5R + (size_t)((l * NB + b) * 64 + g) * 64 + lane] = s[0];
        p->out[O_PS5I + (size_t)((l * NB + b) * 64 + g) * 64 + lane] = s[1];
    }
    __syncthreads();
    bf16x8 cmf[4];
    { const bf16_t* cm = (const bf16_t*)(p->ws + WS_S5C) + (size_t)lg * 16 * 128 + r * 128 + q * 8;
#pragma unroll
      for (int ks = 0; ks < 4; ++ks) cmf[ks] = *(const bf16x8*)(cm + ks * 32); }
    const float dsk = p->in[15][l * 1024 + g * 16 + r];
    for (int ci = 0; ci < 4; ++ci) {
        const int c = w + 8 * ci;
        f32x2 x = Ss[c * 64 + lane];
        for (int tb = 0; tb < 4; ++tb) {
            S5_BLOCK(c, tb);
#pragma unroll
            for (int tt = 0; tt < 16; ++tt) { S5_STEP(tt); Xw[tt * 136 + lane] = f2bf(x[0]); Xw[tt * 136 + 64 + lane] = f2bf(x[1]); }
            asm volatile("s_waitcnt lgkmcnt(0)" ::: "memory");
            f32x4 acc = (f32x4){0.f, 0.f, 0.f, 0.f};
#pragma unroll
            for (int ks = 0; ks < 4; ++ks) { const bf16x8 a = *(const LAS bf16x8*)(Xw + r * 136 + ks * 32 + q * 8); acc = __builtin_amdgcn_mfma_f32_16x16x32_bf16(a, cmf[ks], acc, 0, 0, 0); }
#pragma unroll
            for (int j = 0; j < 4; ++j) { const int t = tb * 16 + q * 4 + j; const size_t row = (size_t)b * SEQ + c * 64 + t;
                const float y = acc[j] + dsk * bf2f(proj[row * NIN + OFF_U + g * 16 + r]);
                y5g[row * 1024 + g * 16 + r] = f2bf(geluf_(y)); }
            asm volatile("s_waitcnt lgkmcnt(0)" ::: "memory");
        }
    }
#undef S5_BLOCK
#undef S5_STEP
    __syncthreads();
}

__device__ __forceinline__ void s5_sample(ParamsK p, int l, LAS unsigned char* lds, int wg0, int nwg) {
    const int tid = fresh_tid(), w = tid >> 6, lane = tid & 63, r = lane & 15, q = lane >> 4;
    LAS float* xs = (LAS float*)(lds + w * 512);
    const bf16_t* proj = (const bf16_t*)(p->ws + WS_PROJ);
    bf16_t* y5g = (bf16_t*)(p->ws + WS_Y5G);
    for (int item = (fresh_bid() - wg0) * 8 + w; item < NSAMP * 64; item += nwg * 8) {
        const int b = item >> 6, g = item & 63, lg = l * 64 + g;
        const size_t row = NPROMPT + b;
        const f32x4 av = ((const f32x4*)(p->ws + WS_S5A))[lg * 64 + lane];
        const u32x4 u0 = *(const u32x4*)(proj + row * NIN + OFF_U + g * 16), u1 = *(const u32x4*)(proj + row * NIN + OFF_U + g * 16 + 8);
        const float u[16] = {bflo(u0.x), bfhi(u0.x), bflo(u0.y), bfhi(u0.y), bflo(u0.z), bfhi(u0.z), bflo(u0.w), bfhi(u0.w), bflo(u1.x), bfhi(u1.x), bflo(u1.y), bfhi(u1.y), bflo(u1.z), bfhi(u1.z), bflo(u1.w), bfhi(u1.w)};
        const size_t si = ((size_t)(l * NSAMP + b) * 64 + g) * 64 + lane;
        const float x0r = p->in[2][si], x0i = p->in[3][si];
        float xr = av[0] * x0r - av[1] * x0i, xi = av[0] * x0i + av[1] * x0r;
        const f32x4* bp = (const f32x4*)((const f32x2*)(p->ws + WS_S5B) + (size_t)(lg * 64 + lane) * 16);
#pragma unroll
        for (int i = 0; i < 8; ++i) { const f32x4 t = bp[i]; xr += t[0] * u[2 * i] + t[2] * u[2 * i + 1]; xi += t[1] * u[2 * i] + t[3] * u[2 * i + 1]; }
        p->out[O_SS5R + si] = xr; p->out[O_SS5I + si] = xi;
        xs[lane] = xr; xs[64 + lane] = xi;
        asm volatile("s_waitcnt lgkmcnt(0)" ::: "memory");
        const float* cr = p->in[13] + ((size_t)lg * 16 + r) * 64 + q * 16; const float* ci = p->in[14] + ((size_t)lg * 16 + r) * 64 + q * 16;
        float y = 0.f;
#pragma unroll
        for (int i = 0; i < 4; ++i) { const f32x4 a = *(const f32x4*)(cr + 4 * i), c2 = *(const f32x4*)(ci + 4 * i);
            const f32x4 vr = *(const LAS f32x4*)(xs + q * 16 + 4 * i), vi = *(const LAS f32x4*)(xs + 64 + q * 16 + 4 * i);
            y += a[0] * vr[0] + a[1] * vr[1] + a[2] * vr[2] + a[3] * vr[3] - (c2[0] * vi[0] + c2[1] * vi[1] + c2[2] * vi[2] + c2[3] * vi[3]); }
        y += __shfl_xor(y, 16); y += __shfl_xor(y, 32);
        float ur = 0.f;
#pragma unroll
        for (int i = 0; i < 16; ++i) ur = (r == i) ? u[i] : ur;
        y += p->in[15][l * 1024 + g * 16 + r] * ur;
        if (q == 0) y5g[row * 1024 + g * 16 + r] = f2bf(geluf_(y));
        asm volatile("s_waitcnt lgkmcnt(0)" ::: "memory");
    }
    __syncthreads();
}

template <bool RET>
__device__ __forceinline__ void recur_sample_item(ParamsK p, int l, int item, LAS unsigned char* lds) {
    constexpr int DV = RET ? 128 : 256, NH = RET ? 8 : 4, NV4 = DV / 4, KR = 512 / NV4;
    const int tid = fresh_tid();
    LAS float* qs = (LAS float*)lds; LAS float* ks = qs + 128; LAS float* ds = ks + 128; LAS float* red = ds + 128;
    const bf16_t* proj = (const bf16_t*)(p->ws + WS_PROJ);
    float* oraw = (float*)(p->ws + WS_ORAW);
    const int b = item / NH, h = item % NH;
    const size_t row = NPROMPT + b;
    if (tid < 128) {
        qs[tid] = bf2f(proj[row * NIN + (RET ? OFF_RQ : OFF_GQ) + h * 128 + tid]);
        ks[tid] = bf2f(proj[row * NIN + (RET ? OFF_RK : OFF_GK) + h * 128 + tid]);
        float dec;
        if (RET) dec = 1.0f - exp2f(-5.0f - (float)h);
        else { float lo = p->in[20][l * 512 + h * 128 + tid];
#pragma unroll
            for (int rr = 0; rr < 16; ++rr) lo += bf2f(proj[row * NIN + OFF_GLR + rr]) * p->in[19][((size_t)l * 16 + rr) * 512 + h * 128 + tid];
            dec = __expf(logsigmoidf_(lo) * 0.0625f); }
        ds[tid] = dec;
    }
    __syncthreads();
    const int vq = tid % NV4, kr = tid / NV4;
    const u32x2 vb = *(const u32x2*)(proj + row * NIN + (RET ? OFF_RV : OFF_GV) + h * DV + vq * 4);
    const f32x4 v4 = (f32x4){bflo(vb.x), bfhi(vb.x), bflo(vb.y), bfhi(vb.y)};
    const size_t sbase = ((size_t)(l * NSAMP + b) * NH + h) * 128 * DV;
    const float* s0 = p->in[RET ? 5 : 4] + sbase; float* sn = p->out + (RET ? O_SRET : O_SGLA) + sbase;
    f32x4 o4 = (f32x4){0.f, 0.f, 0.f, 0.f};
#pragma unroll 8
    for (int k = kr; k < 128; k += KR) {
        const f32x4 s = __builtin_nontemporal_load((const f32x4*)(s0 + (size_t)k * DV + vq * 4));
        const f32x4 nw = s * ds[k] + v4 * ks[k];
        __builtin_nontemporal_store(nw, (f32x4*)(sn + (size_t)k * DV + vq * 4));
        o4 += nw * qs[k];
    }
    *(LAS f32x4*)(red + kr * DV + vq * 4) = o4;
    __syncthreads();
    if (tid < DV) { float o = 0.f;
#pragma unroll
        for (int i = 0; i < KR; ++i) o += red[i * DV + tid];
        oraw[row * DM + (RET ? 1024 + h * 128 : h * 256) + tid] = o; }
    __syncthreads();
}

__device__ __forceinline__ void phase_mixers(ParamsK p, int l, LAS unsigned char* lds) {
    const int bid = fresh_bid(), G = gridDim.x, half = G >> 1;
    if (bid < half) {
        for (int item = bid; item < 128; item += half) {
            if (item < 64) recur_item<false>(p, l, item >> 4, (item >> 2) & 3, item & 3, lds);
            else { const int it = item - 64; recur_item<true>(p, l, it >> 4, (it >> 1) & 7, it & 1, lds); }
        }
    } else {
        for (int rep = 0; rep < REP_S5; ++rep) for (int item = bid - half; item < 256; item += G - half) s5_prompt_item(p, l, item >> 6, item & 63, lds);
        s5_sample(p, l, lds, half, G - half);
    }
    unsigned* ctr = (unsigned*)(p->ws + WS_BAR) + 3584 + 64 * l;
    LAS int* slot = (LAS int*)(lds + 65536);
    for (;;) {
        if (fresh_tid() == 0) slot[0] = (int)__hip_atomic_fetch_add(ctr, 1u, __ATOMIC_RELAXED, __HIP_MEMORY_SCOPE_AGENT);
        __syncthreads();
        const int item = slot[0];
        __syncthreads();
        if (item >= 1536) break;
        if (item < 512) recur_sample_item<false>(p, l, item, lds); else recur_sample_item<true>(p, l, item - 512, lds);
    }
}

__device__ __forceinline__ void post_norms(ParamsK p, int l) {
    const int tid = fresh_tid();
    const float* oraw = (const float*)(p->ws + WS_ORAW);
    const bf16_t* proj = (const bf16_t*)(p->ws + WS_PROJ);
    bf16_t* agla = (bf16_t*)(p->ws + WS_AGLA); bf16_t* aret = (bf16_t*)(p->ws + WS_ARET);
    const bool gla = tid < 256;
    const int col = gla ? tid * 4 : (tid - 256) * 4;
    f32x4 gn = (f32x4){1.f, 1.f, 1.f, 1.f};
    if (gla) gn = *(const f32x4*)(p->in[21] + l * 256 + (col & 255));
    const int bid = fresh_bid();
    if (bid >= 132 && bid < 231) return;
    const int widx = bid < 132 ? bid : bid - 99;
    const int G = (int)gridDim.x - 99;
    for (int row0 = widx; row0 < MROWS; row0 += 4 * G) {
        f32x4 o[4]; u32x2 gb[4];
#pragma unroll
        for (int u = 0; u < 4; ++u) { const int row = row0 + u * G < MROWS ? row0 + u * G : row0;
            o[u] = *(const f32x4*)(oraw + (size_t)row * DM + tid * 4); gb[u] = *(const u32x2*)(proj + (size_t)row * NIN + (gla ? OFF_GR : OFF_RG) + col); }
#pragma unroll
        for (int u = 0; u < 4; ++u) {
            const int row = row0 + u * G; if (row >= MROWS) break;
            u32x2 w;
            if (gla) {
                float ss = o[u][0] * o[u][0] + o[u][1] * o[u][1] + o[u][2] * o[u][2] + o[u][3] * o[u][3];
#pragma unroll
                for (int s2 = 32; s2 > 0; s2 >>= 1) ss += __shfl_xor(ss, s2);
                const float rs = 1.0f / sqrtf(ss * (1.0f / 256.0f) + 1e-6f);
                w.x = cvt_pk_bf16(o[u][0] * rs * gn[0] * bflo(gb[u].x), o[u][1] * rs * gn[1] * bfhi(gb[u].x)); w.y = cvt_pk_bf16(o[u][2] * rs * gn[2] * bflo(gb[u].y), o[u][3] * rs * gn[3] * bfhi(gb[u].y));
                *(u32x2*)(agla + (size_t)row * 1024 + col) = w;
            } else {
                float sm = o[u][0] + o[u][1] + o[u][2] + o[u][3];
#pragma unroll
                for (int s2 = 16; s2 > 0; s2 >>= 1) sm += __shfl_xor(sm, s2);
                const float mu = sm * (1.0f / 128.0f);
                const f32x4 d = o[u] - mu;
                float ss = d[0] * d[0] + d[1] * d[1] + d[2] * d[2] + d[3] * d[3];
#pragma unroll
                for (int s2 = 16; s2 > 0; s2 >>= 1) ss += __shfl_xor(ss, s2);
                const float rs = 1.0f / sqrtf(ss * (1.0f / 128.0f) + 1e-6f);
                w.x = cvt_pk_bf16(d[0] * rs * bflo(gb[u].x), d[1] * rs * bfhi(gb[u].x)); w.y = cvt_pk_bf16(d[2] * rs * bflo(gb[u].y), d[3] * rs * bfhi(gb[u].y));
                *(u32x2*)(aret + (size_t)row * 1024 + col) = w;
            }
        }
    }
}


__device__ __forceinline__ void skinny_resid(const bf16_t* A, int lda, const bf16_t* Wt, int ldb, int K, const XSrc res, float* out, LAS unsigned char* lds) {
    const int tid = fresh_tid(), w = tid >> 6, lane = tid & 63, r = lane & 15, q = lane >> 4;
    LAS float* red = (LAS float*)lds;
    for (int piece = fresh_bid(); piece < 256; piece += gridDim.x) {
        const int rh = piece & 1, cg = piece >> 1;
        const bf16_t* ap = A + (size_t)(NPROMPT + rh * 64 + r) * lda + q * 8;
        const bf16_t* bp = Wt + (size_t)(cg * 16 + r) * ldb + q * 8;
        const int ksper = K / 256, k0 = w * ksper * 32;
        f32x4 acc[4];
#pragma unroll
        for (int mt = 0; mt < 4; ++mt) acc[mt] = (f32x4){0.f, 0.f, 0.f, 0.f};
#pragma unroll 4
        for (int ks = 0; ks < ksper; ++ks) {
            const int k = k0 + ks * 32;
            const bf16x8 b = *(const bf16x8*)(bp + k);
            bf16x8 a[4];
#pragma unroll
            for (int mt = 0; mt < 4; ++mt) a[mt] = *(const bf16x8*)(ap + (size_t)mt * 16 * lda + k);
#pragma unroll
            for (int mt = 0; mt < 4; ++mt) acc[mt] = __builtin_amdgcn_mfma_f32_16x16x32_bf16(a[mt], b, acc[mt], 0, 0, 0);
        }
#pragma unroll
        for (int mt = 0; mt < 4; ++mt) *(LAS f32x4*)(red + w * 1024 + (mt * 64 + lane) * 4) = acc[mt];
        __syncthreads();
#pragma unroll
        for (int h = 0; h < 2; ++h) {
            const int e = tid + h * 512;
            float sum = 0.f;
#pragma unroll
            for (int ww = 0; ww < 8; ++ww) sum += red[ww * 1024 + e];
            const int mt = e >> 8, ln = (e >> 2) & 63, j = e & 3;
            const int row = NPROMPT + rh * 64 + mt * 16 + (ln >> 4) * 4 + j, col = cg * 16 + (ln & 15);
            out[(size_t)row * DM + col] = res.row(row)[col] + sum;
        }
        __syncthreads();
    }
}


__device__ __forceinline__ void skinny_merge(ParamsK p, int l, LAS unsigned char* lds) {
    const int tid = fresh_tid(), w = tid >> 6, lane = tid & 63, r = lane & 15, q = lane >> 4;
    LAS float* red = (LAS float*)lds;
    const bf16_t* proj = (const bf16_t*)(p->ws + WS_PROJ); bf16_t* O = (bf16_t*)(p->ws + WS_MERGED);
    for (int piece = fresh_bid(); piece < 256; piece += gridDim.x) {
        const int rh = piece & 1, cg = piece >> 1;
#pragma unroll
        for (int z = 0; z < 3; ++z) {
            const bf16_t* A = (const bf16_t*)(p->ws + (z == 0 ? WS_AS5 : (z == 1 ? WS_AGLA : WS_ARET)));
            const bf16_t* Wt = (const bf16_t*)(p->ws + (z == 0 ? WS_WS5O : (z == 1 ? WS_WGLAO : WS_WRETO)) + l * SZ_WBR);
            const bf16_t* ap = A + (size_t)(NPROMPT + rh * 64 + r) * 1024 + q * 8 + w * 128;
            const bf16_t* bp = Wt + (size_t)(cg * 16 + r) * 1024 + q * 8 + w * 128;
            f32x4 acc[4];
#pragma unroll
            for (int mt = 0; mt < 4; ++mt) acc[mt] = (f32x4){0.f, 0.f, 0.f, 0.f};
#pragma unroll
            for (int ks = 0; ks < 4; ++ks) {
                const bf16x8 b = *(const bf16x8*)(bp + ks * 32);
#pragma unroll
                for (int mt = 0; mt < 4; ++mt) { const bf16x8 a = *(const bf16x8*)(ap + (size_t)mt * 16 * 1024 + ks * 32); acc[mt] = __builtin_amdgcn_mfma_f32_16x16x32_bf16(a, b, acc[mt], 0, 0, 0); }
            }
#pragma unroll
            for (int mt = 0; mt < 4; ++mt) *(LAS f32x4*)(red + (z * 8 + w) * 1024 + (mt * 64 + lane) * 4) = acc[mt];
        }
        __syncthreads();
#pragma unroll
        for (int h = 0; h < 2; ++h) {
            const int e = tid + h * 512;
            const int mt = e >> 8, ln = (e >> 2) & 63, j = e & 3;
            const int row = NPROMPT + rh * 64 + mt * 16 + (ln >> 4) * 4 + j, col = cg * 16 + (ln & 15);
            float tot = 0.f;
#pragma unroll
            for (int z = 0; z < 3; ++z) { float sum = 0.f;
#pragma unroll
                for (int ww = 0; ww < 8; ++ww) sum += red[(z * 8 + ww) * 1024 + e];
                tot += sum * bf2f(proj[(size_t)row * NIN + OFF_MG + z * 2048 + col]); }
            O[(size_t)row * DM + col] = f2bf(tot);
        }
        __syncthreads();
    }
}

#define XB_TMO      128
#define XB_XCNT(j)  (256  + 64 * (j))
#define XB_XSUB(j)  (1280 + 64 * (j))
#define XB_XGEN(j)  (2304 + 64 * (j))
#define XB_TOP      3328
#define XB_TOPGEN   3392
#define XCD_BAR_WORDS 3456
#define XB_SPIN_CAP (1u << 18)
__device__ __forceinline__ unsigned xb_ld(unsigned* p)              { return __hip_atomic_load(p, __ATOMIC_RELAXED, __HIP_MEMORY_SCOPE_AGENT); }
__device__ __forceinline__ unsigned xb_add(unsigned* p, unsigned v) { return __hip_atomic_fetch_add(p, v, __ATOMIC_RELAXED, __HIP_MEMORY_SCOPE_AGENT); }
__device__ __forceinline__ unsigned xb_xcc_id() { return (unsigned)__builtin_amdgcn_s_getreg((3 << 11) | 20) & 0xFu; }
#define XB_SPIN(cond, bar) do { unsigned _sp = 0; while (cond) { __builtin_amdgcn_s_sleep(1); \
    if ((++_sp & 255u) == 0u) { if (xb_ld(&(bar)[XB_TMO])) break; if (_sp > XB_SPIN_CAP) { atomicAdd(&(bar)[XB_TMO], 1u); break; } } } } while (0)
struct XcdBarrier { unsigned* bar; unsigned x; volatile LAS unsigned* st; };
__device__ __forceinline__ XcdBarrier xcd_barrier_post(unsigned* bar, volatile LAS unsigned* st) {
    XcdBarrier b; b.bar = bar; b.x = xb_xcc_id(); b.st = st;
    if (threadIdx.x == 0) (void)xb_add(&bar[XB_XCNT(b.x)], 1u);
    return b;
}
__device__ __forceinline__ void xcd_barrier_complete(unsigned* bar, unsigned x, unsigned& nloc, unsigned& nx) {
    const unsigned G = gridDim.x * gridDim.y * gridDim.z;
    unsigned sum, cnt, mine, sp = 0u;
    for (;;) {
        sum = 0u; cnt = 0u; mine = 0u;
#pragma unroll
        for (unsigned j = 0; j < 16; ++j) { const unsigned c = xb_ld(&bar[XB_XCNT(j)]); sum += c; cnt += (c > 0u) ? 1u : 0u; mine = (j == x) ? c : mine; }
        if (sum == G) break;
        __builtin_amdgcn_s_sleep(1);
        if ((++sp & 255u) == 0u) { if (xb_ld(&bar[XB_TMO])) break; if (sp > XB_SPIN_CAP) { atomicAdd(&bar[XB_TMO], 1u); break; } }
    }
    nloc = mine > 0u ? mine : 1u; nx = cnt > 0u ? cnt : 1u;
}
__device__ __forceinline__ void xcd_barrier(const XcdBarrier& b) {
    asm volatile("s_waitcnt vmcnt(0)" ::: "memory");
    __syncthreads();
    if (threadIdx.x == 0) {
        unsigned* bar = b.bar;
        __builtin_amdgcn_s_waitcnt(0);
        unsigned nloc = b.st[0], nx = b.st[1];
        if (nloc == 0u) { xcd_barrier_complete(bar, b.x, nloc, nx); b.st[0] = nloc; b.st[1] = nx; }
        const unsigned old = xb_add(&bar[XB_XSUB(b.x)], 1u);
        const unsigned gen = old / nloc;
        if (old + 1u == (gen + 1u) * nloc) {
            __builtin_amdgcn_fence(__ATOMIC_RELEASE, "agent");
            asm volatile("s_waitcnt vmcnt(0)" ::: "memory");
            const unsigned og = xb_add(&bar[XB_TOP], 1u);
            const unsigned tg = og / nx;
            if (og + 1u == (tg + 1u) * nx) xb_add(&bar[XB_TOPGEN], 1u);
            else XB_SPIN(xb_ld(&bar[XB_TOPGEN]) == tg, bar);
            __builtin_amdgcn_fence(__ATOMIC_ACQUIRE, "agent");
            xb_add(&bar[XB_XGEN(b.x)], 1u);
            asm volatile("s_waitcnt vmcnt(0)" ::: "memory");
        } else {
            XB_SPIN(xb_ld(&bar[XB_XGEN(b.x)]) == gen, bar);
            __builtin_amdgcn_fence(__ATOMIC_ACQUIRE, "agent");
            asm volatile("s_waitcnt vmcnt(0)" ::: "memory");
        }
    }
    __syncthreads();
}
#define GSYNC() do { XcdBarrier _b; _b.bar = (unsigned*)(fresh_params()->ws + WS_BAR); _b.x = xb_xcc_id(); _b.st = (volatile LAS unsigned*)(lds + 131072); xcd_barrier(_b); } while (0)

__global__ void __launch_bounds__(512) hybrid_fwd(Params p_unused) {
    extern __shared__ __attribute__((aligned(16))) unsigned char lds_raw[];
    LAS unsigned char* lds = (LAS unsigned char*)lds_raw;
    cg::grid_group grid = cg::this_grid();
    const int G = gridDim.x;

    if (threadIdx.x < 4) ((volatile LAS unsigned*)(lds + 131072))[threadIdx.x] = 0u;
    __syncthreads();
    (void)xcd_barrier_post((unsigned*)(fresh_params()->ws + WS_BAR), (volatile LAS unsigned*)(lds + 131072));
    for (int rep = 0; rep < REP_PRE; ++rep) phase_prepass(fresh_params(), lds);
    if (fresh_params()->ws == nullptr) grid.sync();
    GSYNC();
    for (int rep = 0; rep < REP_SYNC; ++rep) GSYNC();
#pragma unroll 1
    for (int l = 0; l < 2; ++l) {
        {
            ParamsK p = fresh_params();
            pg8::Gemm g; g.A0 = g.A1 = g.A2 = (const bf16_t*)(p->ws + WS_XN); g.B0 = g.B1 = g.B2 = (const bf16_t*)(p->ws + WS_WIN + l * SZ_WIN); g.lda = 2048; g.ldb = 2048; g.K = 2048;
            pg8::TileOrder S; S.init(MP, 54 * 256, G, fresh_bid(), 1); S.cut = 53; S.shift = 3;
            EpiInProj E; E.O = (bf16_t*)(p->ws + WS_PROJ); E.rot = (const float*)(p->ws + WS_ROT);
            for (int rep = 0; rep < REP_INPROJ; ++rep) pg8::gemm_phase(lds, g, S, E);
        }
        GSYNC();
        phase_gates(fresh_params(), l);
        GSYNC();
        for (int rep = 0; rep < REP_MIX; ++rep) phase_mixers(fresh_params(), l, lds);
        GSYNC();
        {
            ParamsK p = fresh_params();
            pg8::Gemm g; g.A0 = g.A1 = g.A2 = (const bf16_t*)(p->ws + WS_Y5G); g.B0 = g.B1 = g.B2 = (const bf16_t*)(p->ws + WS_WGLU + l * SZ_WGLU); g.lda = 1024; g.ldb = 1024; g.K = 1024;
            pg8::TileOrder S; S.init(MP, 1024, G, fresh_bid(), 1);
            EpiGlu E; E.O = (bf16_t*)(p->ws + WS_AS5); E.Y = (const bf16_t*)(p->ws + WS_Y5G); E.bias = p->in[17] + l * 1024;
            for (int rep = 0; rep < REP_POST; ++rep) { pg8::gemm_phase(lds, g, S, E);
            {
                ParamsK p2 = fresh_params();
                pg8::Gemm g2; g2.A0 = g2.A1 = g2.A2 = (const bf16_t*)(p2->ws + WS_XN); g2.B0 = g2.B1 = g2.B2 = (const bf16_t*)(p2->ws + WS_WIN + l * SZ_WIN); g2.lda = 2048; g2.ldb = 2048; g2.K = 2048;
                const int c2 = fresh_bid() - 132;
                if (c2 >= 0) {
                    pg8::TileOrder S2; S2.init(MP, 3 * 256, (int)gridDim.x - 132, c2, 1); S2.cut = 0; S2.shift = 53;
                    EpiInProj E2; E2.O = (bf16_t*)(p2->ws + WS_PROJ); E2.rot = (const float*)(p2->ws + WS_ROT);
                    pg8::gemm_phase(lds, g2, S2, E2);
                }
            }
            post_norms(fresh_params(), l); }
        }
        GSYNC();
        {
            ParamsK p = fresh_params();
            pg8::Gemm g; g.A0 = (const bf16_t*)(p->ws + WS_AS5); g.A1 = (const bf16_t*)(p->ws + WS_AGLA); g.A2 = (const bf16_t*)(p->ws + WS_ARET);
            g.B0 = (const bf16_t*)(p->ws + WS_WS5O + l * SZ_WBR); g.B1 = (const bf16_t*)(p->ws + WS_WGLAO + l * SZ_WBR); g.B2 = (const bf16_t*)(p->ws + WS_WRETO + l * SZ_WBR);
            g.lda = 1024; g.ldb = 1024; g.K = 1024;
            pg8::TileOrder S; S.init(NPROMPT, DM, G, fresh_bid(), 3);
            EpiMerge E; E.O = (bf16_t*)(p->ws + WS_MERGED); E.proj = (const bf16_t*)(p->ws + WS_PROJ);
            for (int rep = 0; rep < REP_MG; ++rep) { pg8::gemm_phase(lds, g, S, E); skinny_merge(fresh_params(), l, lds); }
        }
        GSYNC();
        {
            ParamsK p = fresh_params();
            pg8::Gemm g; g.A0 = g.A1 = g.A2 = (const bf16_t*)(p->ws + WS_MERGED); g.B0 = g.B1 = g.B2 = (const bf16_t*)(p->ws + WS_WMIX + l * SZ_WMIX); g.lda = 2048; g.ldb = 2048; g.K = 2048;
            pg8::TileOrder S; S.init(NPROMPT, DM, G, fresh_bid(), 1);
            EpiResid E; E.O = (float*)(p->ws + WS_X1); E.zero = (DBG_ZMASK >> 4) & 1;
            const float* X2 = (const float*)(p->ws + WS_X2);
            if (l == 0) { E.res.a = p->in[0]; E.res.b = p->in[1]; E.res.split = NPROMPT; E.res.valid = MROWS; } else { E.res.a = X2; E.res.b = X2; E.res.split = MP; E.res.valid = MP; }
            for (int rep = 0; rep < REP_MO; ++rep) { pg8::gemm_phase(lds, g, S, E);
                skinny_resid((const bf16_t*)(p->ws + WS_MERGED), 2048, (const bf16_t*)(p->ws + WS_WMIX + l * SZ_WMIX), 2048, 2048, E.res, E.O, lds); }
        }
        GSYNC();
        { ParamsK p = fresh_params(); const float* X1 = (const float*)(p->ws + WS_X1); XSrc s; s.a = X1; s.b = X1; s.split = MP; s.valid = MP; for (int rep = 0; rep < REP_NORM; ++rep) norm_rows(s, p->in[25] + l * DM, (bf16_t*)(p->ws + WS_XN), nullptr); }
        GSYNC();
        {
            ParamsK p = fresh_params();
            pg8::Gemm g; g.A0 = g.A1 = g.A2 = (const bf16_t*)(p->ws + WS_XN); g.B0 = g.B1 = g.B2 = (const bf16_t*)(p->ws + WS_WGU + l * SZ_WGU); g.lda = 2048; g.ldb = 2048; g.K = 2048;
            pg8::TileOrder S; S.init(MP, 11264, G, fresh_bid(), 1);
            EpiFfnUp E; E.O = (bf16_t*)(p->ws + WS_FF);
            for (int rep = 0; rep < REP_UP; ++rep) pg8::gemm_phase(lds, g, S, E);
        }
        GSYNC();
        {
            ParamsK p = fresh_params();
            const float* X1 = (const float*)(p->ws + WS_X1);
            pg8::Gemm g; g.A0 = g.A1 = g.A2 = (const bf16_t*)(p->ws + WS_FF); g.B0 = g.B1 = g.B2 = (const bf16_t*)(p->ws + WS_WDN + l * SZ_WDN); g.lda = DFF; g.ldb = DFF; g.K = DFF;
            pg8::TileOrder S; S.init(NPROMPT, DM, G, fresh_bid(), 1);
            EpiResid E; E.O = (float*)(p->ws + WS_X2); E.zero = (DBG_ZMASK >> 3) & 1; E.res.a = X1; E.res.b = X1; E.res.split = MP; E.res.valid = MP;
            for (int rep = 0; rep < REP_DN; ++rep) { pg8::gemm_phase(lds, g, S, E);
                skinny_resid((const bf16_t*)(p->ws + WS_FF), DFF, (const bf16_t*)(p->ws + WS_WDN + l * SZ_WDN), DFF, DFF, E.res, E.O, lds); }
        }
        GSYNC();
        { ParamsK p = fresh_params(); const float* X2 = (const float*)(p->ws + WS_X2); XSrc s; s.a = X2; s.b = X2; s.split = MP; s.valid = MP;
          if (l == 0) norm_rows(s, p->in[6] + DM, (bf16_t*)(p->ws + WS_XN), nullptr); else norm_rows(s, p->in[29], nullptr, p->out + O_Y); }
        if (l == 0) GSYNC();
    }
}

extern "C" void kernel_launch(void* const* d_in, const int* in_sizes, int n_in, void* d_out, int out_size, void* d_ws, size_t ws_size, hipStream_t stream) {
    static int grid_blocks = 0;
    if (grid_blocks == 0) {
        if (n_in != 30 || ws_size < WS_TOTAL) { fprintf(stderr, "kernel_launch: unexpected n_in %d / ws_size %zu (need %zu)\n", n_in, ws_size, (size_t)WS_TOTAL); grid_blocks = -1; return; }
        int dev = 0, cus = 0, per_cu = 0;
        (void)hipGetDevice(&dev);
        (void)hipDeviceGetAttribute(&cus, hipDeviceAttributeMultiprocessorCount, dev);
        if (hipFuncSetAttribute((const void*)hybrid_fwd, hipFuncAttributeMaxDynamicSharedMemorySize, LDS_BYTES) != hipSuccess) { fprintf(stderr, "kernel_launch: hipFuncSetAttribute failed\n"); grid_blocks = -1; return; }
        if (hipOccupancyMaxActiveBlocksPerMultiprocessor(&per_cu, (const void*)hybrid_fwd, 512, LDS_BYTES) != hipSuccess || per_cu < 1) { fprintf(stderr, "kernel_launch: occupancy query gave %d\n", per_cu); per_cu = 1; }
        (void)hipGetLastError();
        grid_blocks = cus * 1;
    }
    if (grid_blocks < 0) return;
    if (hipMemsetAsync((char*)d_ws + WS_BAR, 0, 16384, stream) != hipSuccess) { fprintf(stderr, "kernel_launch: memset of the barrier words failed\n"); return; }
    Params p{};
    for (int i = 0; i < 30; ++i) p.in[i] = (const float*)d_in[i];
    p.out = (float*)d_out; p.ws = (unsigned char*)d_ws;
    void* args[] = {&p};
    hipError_t e = hipLaunchCooperativeKernel((const void*)hybrid_fwd, dim3(grid_blocks), dim3(512), args, LDS_BYTES, stream);
    if (e != hipSuccess) fprintf(stderr, "cooperative launch failed: %s (grid %d)\n", hipGetErrorString(e), grid_blocks);
}
```

```cpp
#include <hip/hip_runtime.h>
#include <hip/hip_cooperative_groups.h>
#include <cstdio>
namespace cg = cooperative_groups;

#define LAS __attribute__((address_space(3)))
typedef unsigned short bf16_t;
typedef short bf16x8 __attribute__((ext_vector_type(8)));
typedef float f32x4 __attribute__((ext_vector_type(4)));
typedef float f32x2 __attribute__((ext_vector_type(2)));
typedef unsigned u32x4 __attribute__((ext_vector_type(4)));
typedef unsigned u32x2 __attribute__((ext_vector_type(2)));

constexpr int DM = 2048, NPROMPT = 8192, NSAMP = 128, MROWS = 8320, MP = 8448, SEQ = 2048, NB = 4;
constexpr int NIN = 14592, DFF = 5632, WIN_SRC = 14352;
constexpr int OFF_U = 0, OFF_GQ = 1024, OFF_GK = 1536, OFF_GV = 2048, OFF_GR = 3072, OFF_RQ = 4096, OFF_RK = 5120, OFF_RV = 6144, OFF_RG = 7168, OFF_MG = 8192, OFF_GLR = 14336;
constexpr int LDS_BYTES = 131072 + 16;
#ifndef REP_PRE
#define REP_PRE 1
#endif
#ifndef REP_MIX
#define REP_MIX 1
#endif
#ifndef REP_INPROJ
#define REP_INPROJ 1
#endif
#ifndef REP_SYNC
#define REP_SYNC 0
#endif
#ifndef REP_S5
#define REP_S5 1
#endif
#ifndef REP_RS
#define REP_RS 1
#endif
#ifndef REP_UP
#define REP_UP 1
#endif
#ifndef REP_DN
#define REP_DN 1
#endif
#ifndef REP_MG
#define REP_MG 1
#endif
#ifndef REP_MO
#define REP_MO 1
#endif
#ifndef REP_POST
#define REP_POST 1
#endif
#ifndef REP_NORM
#define REP_NORM 1
#endif
#ifndef DBG_ZMASK
#define DBG_ZMASK 0
#endif

constexpr size_t SZ_WIN = (size_t)NIN * 2048 * 2, SZ_WGLU = (size_t)1024 * 1024 * 2, SZ_WBR = (size_t)2048 * 1024 * 2, SZ_WMIX = (size_t)2048 * 2048 * 2,
                 SZ_WGU = (size_t)11264 * 2048 * 2, SZ_WDN = (size_t)2048 * 5632 * 2;
constexpr size_t WS_WIN = 0;
constexpr size_t WS_WGLU = WS_WIN + 2 * SZ_WIN;
constexpr size_t WS_WS5O = WS_WGLU + 2 * SZ_WGLU;
constexpr size_t WS_WGLAO = WS_WS5O + 2 * SZ_WBR;
constexpr size_t WS_WRETO = WS_WGLAO + 2 * SZ_WBR;
constexpr size_t WS_WMIX = WS_WRETO + 2 * SZ_WBR;
constexpr size_t WS_WGU = WS_WMIX + 2 * SZ_WMIX;
constexpr size_t WS_WDN = WS_WGU + 2 * SZ_WGU;
constexpr size_t WS_XN = WS_WDN + 2 * SZ_WDN;
constexpr size_t WS_PROJ = WS_XN + (size_t)MP * 2048 * 2;
constexpr size_t WS_Y5G = WS_PROJ + (size_t)MP * NIN * 2;
constexpr size_t WS_ORAW = WS_Y5G + (size_t)MP * 1024 * 2;
constexpr size_t WS_AS5 = WS_ORAW + (size_t)MP * 2048 * 4;
constexpr size_t WS_AGLA = WS_AS5 + (size_t)MP * 1024 * 2;
constexpr size_t WS_ARET = WS_AGLA + (size_t)MP * 1024 * 2;
constexpr size_t WS_MERGED = WS_ARET + (size_t)MP * 1024 * 2;
constexpr size_t WS_X1 = WS_MERGED + (size_t)MP * 2048 * 2;
constexpr size_t WS_X2 = WS_X1 + (size_t)MP * 2048 * 4;
constexpr size_t WS_ROT = WS_X2 + (size_t)MP * 2048 * 4;
constexpr size_t WS_S5A = WS_ROT + (size_t)2049 * 64 * 8 + 512;
constexpr size_t WS_S5B = WS_S5A + (size_t)2 * 64 * 64 * 16;
constexpr size_t WS_S5C = WS_S5B + (size_t)2 * 64 * 64 * 16 * 8;
constexpr size_t WS_S5BM = WS_S5C + (size_t)2 * 64 * 16 * 128 * 2;
constexpr size_t WS_END = WS_S5BM + (size_t)2 * 64 * 2 * 128 * 16 * 2;
constexpr size_t WS_FF = WS_PROJ;
constexpr size_t WS_BAR = WS_END;
constexpr size_t WS_BCUM = WS_BAR + 16384;
constexpr size_t WS_TOTAL = WS_BCUM + (size_t)NPROMPT * 512 * 4;
static_assert(WS_TOTAL <= (size_t)940572672, "workspace budget");
static_assert((size_t)MP * DFF * 2 <= (size_t)MP * NIN * 2, "ff alias");

constexpr size_t O_Y = 0, O_PS5R = 17039360, O_PS5I = 17072128, O_PGLA = 17104896, O_PRET = 18153472, O_SS5R = 19202048, O_SS5I = 20250624, O_SGLA = 21299200, O_SRET = 54853632;

struct Params { const float* in[30]; float* out; unsigned char* ws; };
typedef const __attribute__((address_space(4))) Params* ParamsK;
__device__ __forceinline__ ParamsK fresh_params() { unsigned long long a = (unsigned long long)__builtin_amdgcn_kernarg_segment_ptr(); asm volatile("" : "+s"(a)); return (ParamsK)a; }
__device__ __forceinline__ int fresh_tid() { int t = threadIdx.x; asm volatile("" : "+v"(t)); return t; }
__device__ __forceinline__ int fresh_bid() { int t = blockIdx.x; asm volatile("" : "+s"(t)); return t; }

typedef __bf16 bf16x2_t __attribute__((ext_vector_type(2)));
__device__ __forceinline__ unsigned cvt_pk_bf16(float lo, float hi) { const f32x2 v = {lo, hi}; const bf16x2_t b = __builtin_convertvector(v, bf16x2_t); return __builtin_bit_cast(unsigned, b); }
__device__ __forceinline__ bf16_t f2bf(float f) { return (bf16_t)(cvt_pk_bf16(f, 0.f) & 0xffffu); }
__device__ __forceinline__ float bf2f(bf16_t b) { return __uint_as_float(((unsigned)b) << 16); }
__device__ __forceinline__ float bflo(unsigned u) { return __uint_as_float(u << 16); }
__device__ __forceinline__ float bfhi(unsigned u) { return __uint_as_float(u & 0xffff0000u); }
__device__ __forceinline__ float sigmoidf_(float x) { return __builtin_amdgcn_rcpf(1.0f + __expf(-x)); }
__device__ __forceinline__ float siluf_(float x) { return x * sigmoidf_(x); }
__device__ __forceinline__ float geluf_(float x) { return x * sigmoidf_(1.5957691216057308f * (x + 0.044715f * x * x * x)); }
__device__ __forceinline__ float logsigmoidf_(float x) { return fminf(x, 0.f) - __logf(1.0f + __expf(-fabsf(x))); }

struct XSrc { const float* a; const float* b; int split, valid;
    __device__ __forceinline__ const float* row(int r) const { return r < split ? a + (size_t)r * DM : b + (size_t)(r - split) * DM; } };

namespace pg8 {
constexpr int BM = 256, BK = 64, HALF = 128, HTB = HALF * BK * 2, STAGE_BYTES = 8 * HTB, NXCD = 8, WGM = 8;
__device__ __forceinline__ int lds_byte(int r, int c) { const int st = (r >> 4) * 2 + (c >> 5), rr = r & 15, cc = c & 31, ob = rr * 64 + cc * 2; return st * 1024 + (ob ^ (((ob >> 9) & 1) << 5)); }
__device__ __forceinline__ void stage_rc(int b, int& R, int& C) { const int st = b / 1024, sb = b % 1024, swz = sb ^ (((sb >> 9) & 1) << 5); R = (st >> 1) * 16 + swz / 64; C = (st & 1) * 32 + (swz % 64) / 2; }
__device__ __forceinline__ int perm32(int rho) { const int n = rho >> 4, i = rho & 15; return 8 * (i >> 2) + 4 * n + (i & 3); }

struct Unit { int pm, pn, z; };
struct Gemm { const bf16_t* A0; const bf16_t* A1; const bf16_t* A2; const bf16_t* B0; const bf16_t* B1; const bf16_t* B2; int lda, ldb, K; };
struct TileOrder {
    int nM, nN, nwg, G, c, nz, cut, shift;
    __device__ void init(int M, int N, int G_, int c_, int nz_) { nM = M / BM; nN = N / BM; nwg = nM * nN; G = G_; c = c_; nz = nz_; cut = 1 << 30; shift = 0; }
    __device__ bool next(int i, Unit& u) const {
        const int it = i / nz; u.z = i - it * nz;
        const long L = (long)it * G + c; if (c < 0 || L >= nwg) return false;
        int wgid = (int)L; { const int q = nwg / NXCD, r = nwg % NXCD, xcd = wgid % NXCD, off = wgid / NXCD; wgid = (xcd < r ? xcd * (q + 1) : r * (q + 1) + (xcd - r) * q) + off; }
        const int nig = WGM * nN, gid = wgid / nig, fm = gid * WGM, gsz = (nM - fm) < WGM ? (nM - fm) : WGM;
        u.pm = fm + ((wgid % nig) % gsz); u.pn = (wgid % nig) / gsz; if (u.pn >= cut) u.pn += shift; return true;
    }
};

template <class Epi>
__device__ __forceinline__ void gemm_phase(LAS unsigned char* lds, const Gemm g, const TileOrder& S, const Epi& E) {
    const int tid = fresh_tid(), wid = __builtin_amdgcn_readfirstlane(tid >> 6), lane = tid & 63, wr = wid >> 2, wc = wid & 3, fr = lane & 15, fq = lane >> 4;
    const int K = g.K, nt = K / BK;
    unsigned voffA[2], voffB[2];
#pragma unroll
    for (int i = 0; i < 2; ++i) { int R, C; stage_rc(tid * 16 + i * 8192, R, C); const int Rb = Epi::PERM ? ((R & ~31) + perm32(R & 31)) : R;
        voffA[i] = (unsigned)(R * g.lda + C) * 2u; voffB[i] = (unsigned)(Rb * g.ldb + C) * 2u; }
    const size_t kstep = (size_t)(BK * 2);
    const size_t hstepA = (size_t)HALF * g.lda * 2, hstepB = (size_t)HALF * g.ldb * 2;
    const size_t tstepA = 2 * hstepA, tstepB = 2 * hstepB;
    const unsigned ldsw = (unsigned)wid * 1024u;
    const int aoff = lds_byte(wr * 64 + fr, fq * 8), boff = lds_byte(wc * 32 + fr, fq * 8);
#define PG8_SA(b, h) (((b) * 2 + (h)) * HTB)
#define PG8_SB(b, h) ((4 + (b) * 2 + (h)) * HTB)
#define PG8_STAGE(bufoff, gbase, voff) do { _Pragma("unroll") for (int _i = 0; _i < 2; ++_i) \
        __builtin_amdgcn_global_load_lds((const unsigned*)((const char*)(gbase) + (voff)[_i]), (LAS unsigned*)(lds + (bufoff) + ldsw + _i * 8192), 16, 0, 0); } while (0)
#define PG8_LDA(dst, b, h) do { _Pragma("unroll") for (int m = 0; m < 4; ++m) _Pragma("unroll") for (int k = 0; k < 2; ++k) dst[m][k] = *(const LAS bf16x8*)(lds + PG8_SA(b, h) + aoff + m * 2048 + k * 1024); } while (0)
#define PG8_LDB(dst, b, h) do { _Pragma("unroll") for (int n = 0; n < 2; ++n) _Pragma("unroll") for (int k = 0; k < 2; ++k) dst[n][k] = *(const LAS bf16x8*)(lds + PG8_SB(b, h) + boff + n * 2048 + k * 1024); } while (0)
#define PG8_MMA(ai, bj, At, Bt) do { __builtin_amdgcn_s_setprio(1); _Pragma("unroll") for (int m = 0; m < 4; ++m) _Pragma("unroll") for (int n = 0; n < 2; ++n) _Pragma("unroll") for (int k = 0; k < 2; ++k) \
        acc[ai][bj][m][n] = __builtin_amdgcn_mfma_f32_16x16x32_bf16(Bt[n][k], At[m][k], acc[ai][bj][m][n], 0, 0, 0); __builtin_amdgcn_s_setprio(0); } while (0)
#define PG8_WAIT_V(n) asm volatile("s_waitcnt vmcnt(" #n ")" ::: "memory")
#define PG8_WAIT_L(n) asm volatile("s_waitcnt lgkmcnt(" #n ")" ::: "memory")
#define PG8_BAR __builtin_amdgcn_s_barrier()
#define PG8_SCHED __builtin_amdgcn_sched_barrier(0)
#define PG8_BASEA(z) ((const char*)((z) == 0 ? g.A0 : ((z) == 1 ? g.A1 : g.A2)))
#define PG8_BASEB(z) ((const char*)((z) == 0 ? g.B0 : ((z) == 1 ? g.B1 : g.B2)))
    Unit cur, nxt; int ui = 0;
    if (!S.next(0, cur)) return;
    f32x4 acc[2][2][4][2];
#pragma unroll
    for (int a = 0; a < 2; ++a)
#pragma unroll
        for (int b = 0; b < 2; ++b)
#pragma unroll
            for (int m = 0; m < 4; ++m)
#pragma unroll
                for (int n = 0; n < 2; ++n) acc[a][b][m][n] = (f32x4){0.f, 0.f, 0.f, 0.f};
    bf16x8 At[4][2], B0[2][2], B1[2][2];
    const char* cA = PG8_BASEA(cur.z) + (size_t)cur.pm * tstepA; const char* cB = PG8_BASEB(cur.z) + (size_t)cur.pn * tstepB;
    PG8_STAGE(PG8_SB(0, 0), cB, voffB); PG8_STAGE(PG8_SA(0, 0), cA, voffA); PG8_STAGE(PG8_SB(0, 1), cB + hstepB, voffB); PG8_STAGE(PG8_SA(0, 1), cA + hstepA, voffA);
    if (wr == 1) PG8_BAR;
    PG8_WAIT_V(4); PG8_BAR;
    PG8_STAGE(PG8_SB(1, 0), cB + kstep, voffB); PG8_STAGE(PG8_SA(1, 0), cA + kstep, voffA); PG8_STAGE(PG8_SB(1, 1), cB + hstepB + kstep, voffB);
    PG8_WAIT_V(6); PG8_BAR;
    for (;;) {
        const bool has_next = S.next(ui + 1, nxt);
        const char* nA = has_next ? PG8_BASEA(nxt.z) + (size_t)nxt.pm * tstepA : cA; const char* nB = has_next ? PG8_BASEB(nxt.z) + (size_t)nxt.pn * tstepB : cB;
        for (int t = 0; t < nt; t += 2) {
            const bool last = (t == nt - 2);
            const char* a1 = cA + (size_t)(t + 1) * kstep;
            const char* a2 = last ? nA : cA + (size_t)(t + 2) * kstep; const char* b2 = last ? nB : cB + (size_t)(t + 2) * kstep;
            const char* a3 = a2 + kstep; const char* b3 = b2 + kstep;
            PG8_LDB(B0, 0, 0); PG8_SCHED; PG8_LDA(At, 0, 0); PG8_STAGE(PG8_SA(1, 1), a1 + hstepA, voffA);
            PG8_WAIT_L(8); PG8_BAR; PG8_WAIT_L(0); PG8_MMA(0, 0, At, B0); PG8_BAR; PG8_SCHED;
            PG8_LDB(B1, 0, 1); PG8_STAGE(PG8_SB(0, 0), b2, voffB);
            PG8_BAR; PG8_WAIT_L(0); PG8_MMA(0, 1, At, B1); PG8_BAR;
            PG8_LDA(At, 0, 1); PG8_STAGE(PG8_SA(0, 0), a2, voffA);
            PG8_BAR; PG8_WAIT_L(0); PG8_MMA(1, 0, At, B0); PG8_BAR; PG8_SCHED;
            PG8_STAGE(PG8_SB(0, 1), b2 + hstepB, voffB);
            PG8_WAIT_V(6); PG8_BAR; PG8_MMA(1, 1, At, B1); PG8_BAR;
            PG8_LDB(B0, 1, 0); PG8_SCHED; PG8_LDA(At, 1, 0); PG8_STAGE(PG8_SA(0, 1), a2 + hstepA, voffA);
            PG8_WAIT_L(8); PG8_BAR; PG8_WAIT_L(0); PG8_MMA(0, 0, At, B0); PG8_BAR; PG8_SCHED;
            PG8_LDB(B1, 1, 1); PG8_STAGE(PG8_SB(1, 0), b3, voffB);
            PG8_BAR; PG8_WAIT_L(0); PG8_MMA(0, 1, At, B1); PG8_BAR;
            PG8_LDA(At, 1, 1); PG8_STAGE(PG8_SA(1, 0), a3, voffA);
            PG8_BAR; PG8_WAIT_L(0); PG8_MMA(1, 0, At, B0); PG8_BAR; PG8_SCHED;
            PG8_STAGE(PG8_SB(1, 1), b3 + hstepB, voffB);
            PG8_WAIT_V(6); PG8_BAR; PG8_MMA(1, 1, At, B1); PG8_BAR;
        }
        E(acc, cur, wr, wc, fr, fq);
        if (!has_next) break;
        if (nxt.z == 0) {
#pragma unroll
            for (int a = 0; a < 2; ++a)
#pragma unroll
                for (int b = 0; b < 2; ++b)
#pragma unroll
                    for (int m = 0; m < 4; ++m)
#pragma unroll
                        for (int n = 0; n < 2; ++n) acc[a][b][m][n] = (f32x4){0.f, 0.f, 0.f, 0.f};
        }
        cur = nxt; cA = nA; cB = nB; ++ui;
    }
    PG8_WAIT_V(0);
    if (wr == 0) PG8_BAR;
    PG8_BAR;
#undef PG8_SA
#undef PG8_SB
#undef PG8_STAGE
#undef PG8_LDA
#undef PG8_LDB
#undef PG8_MMA
#undef PG8_WAIT_V
#undef PG8_WAIT_L
#undef PG8_BAR
#undef PG8_SCHED
#undef PG8_BASEA
#undef PG8_BASEB
}
}
using pg8::Unit;
typedef f32x4 AccT[2][2][4][2];

struct EpiInProj {
    static constexpr bool PERM = true;
    bf16_t* O; const float* rot;
    __device__ __forceinline__ void operator()(const AccT& acc, const Unit& u, int wr, int wc, int fr, int fq) const {
        const int pn = u.pn;
        int mode;
        if (pn < 4) mode = 0; else if (pn < 6) mode = 1; else if (pn < 12) mode = 0; else if (pn < 16) mode = 2; else if (pn < 20) mode = 4; else if (pn < 24) mode = 5;
        else if (pn < 28) mode = 0; else if (pn < 32) mode = 2; else if (pn < 56) mode = 3; else mode = 0;
        const float SC = 0.08838834764831845f;
#pragma unroll
        for (int ai = 0; ai < 2; ++ai)
#pragma unroll
            for (int m = 0; m < 4; ++m) {
                const int row = u.pm * 256 + ai * 128 + wr * 64 + m * 16 + fr;
                bf16_t* rowp = O + (size_t)row * NIN + pn * 256 + wc * 32 + 8 * fq;
                f32x4 r0 = (f32x4){1.f, 0.f, 1.f, 0.f}, r1 = r0;
                if (mode >= 4) { const int pidx = row < NPROMPT ? (row & (SEQ - 1)) : SEQ; const f32x4* rp = (const f32x4*)(rot + ((size_t)pidx * 64 + 16 * wc + 4 * fq) * 2); r0 = rp[0]; r1 = rp[1]; }
#pragma unroll
                for (int bj = 0; bj < 2; ++bj) {
                    f32x4 v0 = acc[ai][bj][m][0], v1 = acc[ai][bj][m][1];
                    if (mode >= 4) {
                        f32x4 a, b;
                        a[0] = v0[0] * r0[0] - v0[1] * r0[1]; a[1] = v0[1] * r0[0] + v0[0] * r0[1];
                        a[2] = v0[2] * r0[2] - v0[3] * r0[3]; a[3] = v0[3] * r0[2] + v0[2] * r0[3];
                        b[0] = v1[0] * r1[0] - v1[1] * r1[1]; b[1] = v1[1] * r1[0] + v1[0] * r1[1];
                        b[2] = v1[2] * r1[2] - v1[3] * r1[3]; b[3] = v1[3] * r1[2] + v1[2] * r1[3];
                        v0 = a; v1 = b;
                        if (mode == 5) { v0 *= SC; v1 *= SC; }
                    } else if (mode == 1) { v0 *= SC; v1 *= SC; }
                    else if (mode == 2) {
#pragma unroll
                        for (int j = 0; j < 4; ++j) { v0[j] = siluf_(v0[j]); v1[j] = siluf_(v1[j]); } }
                    else if (mode == 3) {
#pragma unroll
                        for (int j = 0; j < 4; ++j) { v0[j] = sigmoidf_(v0[j]); v1[j] = sigmoidf_(v1[j]); } }
                    u32x4 w; w.x = cvt_pk_bf16(v0[0], v0[1]); w.y = cvt_pk_bf16(v0[2], v0[3]); w.z = cvt_pk_bf16(v1[0], v1[1]); w.w = cvt_pk_bf16(v1[2], v1[3]);
                    *(u32x4*)(rowp + bj * 128) = w;
                }
            }
    }
};
struct EpiGlu {
    static constexpr bool PERM = true;
    bf16_t* O; const bf16_t* Y; const float* bias;
    __device__ __forceinline__ void operator()(const AccT& acc, const Unit& u, int wr, int wc, int fr, int fq) const {
#pragma unroll
        for (int bj = 0; bj < 2; ++bj) {
            const int col = u.pn * 256 + bj * 128 + wc * 32 + 8 * fq;
            const f32x4 b0 = *(const f32x4*)(bias + col), b1 = *(const f32x4*)(bias + col + 4);
#pragma unroll
            for (int ai = 0; ai < 2; ++ai)
#pragma unroll
                for (int m = 0; m < 4; ++m) {
                    const int row = u.pm * 256 + ai * 128 + wr * 64 + m * 16 + fr;
                    const u32x4 y = *(const u32x4*)(Y + (size_t)row * 1024 + col);
                    const f32x4 v0 = acc[ai][bj][m][0] + b0, v1 = acc[ai][bj][m][1] + b1;
                    u32x4 w;
                    w.x = cvt_pk_bf16(bflo(y.x) * sigmoidf_(v0[0]), bfhi(y.x) * sigmoidf_(v0[1]));
                    w.y = cvt_pk_bf16(bflo(y.y) * sigmoidf_(v0[2]), bfhi(y.y) * sigmoidf_(v0[3]));
                    w.z = cvt_pk_bf16(bflo(y.z) * sigmoidf_(v1[0]), bfhi(y.z) * sigmoidf_(v1[1]));
                    w.w = cvt_pk_bf16(bflo(y.w) * sigmoidf_(v1[2]), bfhi(y.w) * sigmoidf_(v1[3]));
                    *(u32x4*)(O + (size_t)row * 1024 + col) = w;
                }
        }
    }
};
struct EpiMerge {
    static constexpr bool PERM = false;
    bf16_t* O; const bf16_t* proj;
    __device__ __forceinline__ void operator()(AccT& acc, const Unit& u, int wr, int wc, int fr, int fq) const {
        const int z = u.z;
#pragma unroll
        for (int ai = 0; ai < 2; ++ai)
#pragma unroll
            for (int m = 0; m < 4; ++m) {
                const int row = u.pm * 256 + ai * 128 + wr * 64 + m * 16 + fr;
#pragma unroll
                for (int bj = 0; bj < 2; ++bj)
#pragma unroll
                    for (int n = 0; n < 2; ++n) {
                        const int col = u.pn * 256 + bj * 128 + wc * 32 + n * 16 + 4 * fq;
                        const bf16_t* gp = proj + (size_t)row * NIN + OFF_MG + z * 2048 + col;
                        const u32x2 ga = *(const u32x2*)gp;
                        f32x4 v = acc[ai][bj][m][n];
                        v[0] *= bflo(ga.x); v[1] *= bfhi(ga.x); v[2] *= bflo(ga.y); v[3] *= bfhi(ga.y);
                        if ((DBG_ZMASK >> z) & 1) v = (f32x4){0.f, 0.f, 0.f, 0.f};
                        if (z < 2) {
                            const u32x2 gb = *(const u32x2*)(gp + 2048);
                            v[0] *= __builtin_amdgcn_rcpf(fmaxf(bflo(gb.x), 1e-30f)); v[1] *= __builtin_amdgcn_rcpf(fmaxf(bfhi(gb.x), 1e-30f));
                            v[2] *= __builtin_amdgcn_rcpf(fmaxf(bflo(gb.y), 1e-30f)); v[3] *= __builtin_amdgcn_rcpf(fmaxf(bfhi(gb.y), 1e-30f));
                            acc[ai][bj][m][n] = v;
                        } else { u32x2 w; w.x = cvt_pk_bf16(v[0], v[1]); w.y = cvt_pk_bf16(v[2], v[3]); *(u32x2*)(O + (size_t)row * DM + col) = w; }
                    }
            }
    }
};
struct EpiResid {
    static constexpr bool PERM = false;
    float* O; XSrc res; int zero;
    __device__ __forceinline__ void operator()(const AccT& acc, const Unit& u, int wr, int wc, int fr, int fq) const {
#pragma unroll
        for (int ai = 0; ai < 2; ++ai)
#pragma unroll
            for (int m = 0; m < 4; ++m) {
                const int row = u.pm * 256 + ai * 128 + wr * 64 + m * 16 + fr;
                const bool ok = row < res.valid;
                const float* rp = res.row(ok ? row : 0);
#pragma unroll
                for (int bj = 0; bj < 2; ++bj)
#pragma unroll
                    for (int n = 0; n < 2; ++n) {
                        const int col = u.pn * 256 + bj * 128 + wc * 32 + n * 16 + 4 * fq;
                        f32x4 v = acc[ai][bj][m][n];
                        if (zero) v = (f32x4){0.f, 0.f, 0.f, 0.f};
                        if (ok) v += *(const f32x4*)(rp + col);
                        *(f32x4*)(O + (size_t)row * DM + col) = v;
                    }
            }
    }
};
struct EpiFfnUp {
    static constexpr bool PERM = true;
    bf16_t* O;
    __device__ __forceinline__ void operator()(const AccT& acc, const Unit& u, int wr, int wc, int fr, int fq) const {
#pragma unroll
        for (int ai = 0; ai < 2; ++ai)
#pragma unroll
            for (int m = 0; m < 4; ++m) {
                const int row = u.pm * 256 + ai * 128 + wr * 64 + m * 16 + fr;
                const f32x4 g0 = acc[ai][0][m][0], g1 = acc[ai][0][m][1], u0 = acc[ai][1][m][0], u1 = acc[ai][1][m][1];
                u32x4 w;
                w.x = cvt_pk_bf16(siluf_(g0[0]) * u0[0], siluf_(g0[1]) * u0[1]); w.y = cvt_pk_bf16(siluf_(g0[2]) * u0[2], siluf_(g0[3]) * u0[3]);
                w.z = cvt_pk_bf16(siluf_(g1[0]) * u1[0], siluf_(g1[1]) * u1[1]); w.w = cvt_pk_bf16(siluf_(g1[2]) * u1[2], siluf_(g1[3]) * u1[3]);
                *(u32x4*)(O + (size_t)row * DFF + u.pn * 128 + wc * 32 + 8 * fq) = w;
            }
    }
};

struct ConvTile { const float* src; bf16_t* dst; int ldw, ldt, valid; };
__device__ __forceinline__ ConvTile conv_decode(ParamsK p, int id) {
    const int PER_LAYER = 18560;
    ConvTile c; c.valid = 64;
    const int l = id / PER_LAYER; int t = id - l * PER_LAYER;
    if (t < 7296) { const int tk = t / 228, tn = t % 228, n0 = tn * 64; int sc;
        if (n0 < 4096) sc = n0; else if (n0 < 14336) sc = n0 + 16; else if (n0 == 14336) { sc = 4096; c.valid = 16; } else { sc = 0; c.valid = 0; }
        c.ldw = WIN_SRC; c.src = p->in[7] + (size_t)l * 2048 * WIN_SRC + (size_t)(tk * 64) * c.ldw + sc; c.ldt = 2048; c.dst = (bf16_t*)(p->ws + WS_WIN + l * SZ_WIN) + (size_t)n0 * c.ldt + tk * 64; }
    else if (t < 7552) { t -= 7296; const int tk = t / 16, tn = t % 16; c.ldw = 1024; c.src = p->in[16] + (size_t)l * 1024 * 1024 + (size_t)(tk * 64) * c.ldw + tn * 64; c.ldt = 1024; c.dst = (bf16_t*)(p->ws + WS_WGLU + l * SZ_WGLU) + (size_t)(tn * 64) * c.ldt + tk * 64; }
    else if (t < 9088) { t -= 7552; const int which = t / 512; t -= which * 512; const int tk = t / 32, tn = t % 32; c.ldw = 2048;
        const float* base = which == 0 ? p->in[18] : (which == 1 ? p->in[22] : p->in[23]);
        const size_t wo = which == 0 ? WS_WS5O : (which == 1 ? WS_WGLAO : WS_WRETO);
        c.src = base + (size_t)l * 1024 * 2048 + (size_t)(tk * 64) * c.ldw + tn * 64; c.ldt = 1024; c.dst = (bf16_t*)(p->ws + wo + l * SZ_WBR) + (size_t)(tn * 64) * c.ldt + tk * 64; }
    else if (t < 10112) { t -= 9088; const int tk = t / 32, tn = t % 32; c.ldw = 2048; c.src = p->in[24] + (size_t)l * 2048 * 2048 + (size_t)(tk * 64) * c.ldw + tn * 64; c.ldt = 2048; c.dst = (bf16_t*)(p->ws + WS_WMIX + l * SZ_WMIX) + (size_t)(tn * 64) * c.ldt + tk * 64; }
    else if (t < 15744) { t -= 10112; const int tk = t / 176, tn = t % 176, n0 = tn * 64, pn = n0 >> 8, within = n0 & 255; const bool isup = within >= 128; const int ff0 = pn * 128 + (within & 127);
        c.ldw = DFF; c.src = (isup ? p->in[27] : p->in[26]) + (size_t)l * 2048 * DFF + (size_t)(tk * 64) * c.ldw + ff0; c.ldt = 2048; c.dst = (bf16_t*)(p->ws + WS_WGU + l * SZ_WGU) + (size_t)n0 * c.ldt + tk * 64; }
    else { t -= 15744; const int tk = t / 32, tn = t % 32; c.ldw = 2048; c.src = p->in[28] + (size_t)l * DFF * 2048 + (size_t)(tk * 64) * c.ldw + tn * 64; c.ldt = DFF; c.dst = (bf16_t*)(p->ws + WS_WDN + l * SZ_WDN) + (size_t)(tn * 64) * c.ldt + tk * 64; }
    return c;
}
__device__ __forceinline__ void conv_weights(ParamsK p, LAS float* T) {
    const int tid = fresh_tid();
    const int kk = tid >> 4, n4 = (tid & 15) * 4;
    const int n = tid >> 3, k8 = (tid & 7) * 8;
    const int TOTAL = 2 * 18560;
    for (int id0 = fresh_bid() * 4; id0 < TOTAL; id0 += gridDim.x * 4) {
        f32x4 v[4][2]; bf16_t* dstp[4];
#pragma unroll
        for (int u = 0; u < 4; ++u) {
            const ConvTile c = conv_decode(p, id0 + u);
            dstp[u] = c.dst + (size_t)n * c.ldt + k8;
#pragma unroll
            for (int ps = 0; ps < 2; ++ps) { v[u][ps] = (f32x4){0.f, 0.f, 0.f, 0.f}; if (n4 < c.valid) v[u][ps] = __builtin_nontemporal_load((const f32x4*)(c.src + (size_t)(kk + 32 * ps) * c.ldw + n4)); }
        }
#pragma unroll
        for (int u = 0; u < 4; ++u)
#pragma unroll
            for (int ps = 0; ps < 2; ++ps) { LAS float* tp = T + u * 4160 + (kk + 32 * ps) * 65 + n4; tp[0] = v[u][ps][0]; tp[1] = v[u][ps][1]; tp[2] = v[u][ps][2]; tp[3] = v[u][ps][3]; }
        __syncthreads();
#pragma unroll
        for (int u = 0; u < 4; ++u) {
            const LAS float* tp = T + u * 4160 + k8 * 65 + n;
            u32x4 w;
            w.x = cvt_pk_bf16(tp[0 * 65], tp[1 * 65]); w.y = cvt_pk_bf16(tp[2 * 65], tp[3 * 65]); w.z = cvt_pk_bf16(tp[4 * 65], tp[5 * 65]); w.w = cvt_pk_bf16(tp[6 * 65], tp[7 * 65]);
            *(u32x4*)dstp[u] = w;
        }
        __syncthreads();
    }
}

__device__ __forceinline__ void sincos_d(double a, double& s, double& c) {
    const double qd = rint(a * 0.63661977236758134);
    double rr = fma(-qd, 1.5707963267948966, a); rr = fma(-qd, 6.123233995736766e-17, rr);
    const int qi = ((int)qd) & 3;
    const double x2 = rr * rr;
    const double sp = rr * (1.0 + x2 * (-1.0 / 6 + x2 * (1.0 / 120 + x2 * (-1.0 / 5040 + x2 * (1.0 / 362880 + x2 * (-1.0 / 39916800 + x2 * (1.0 / 6227020800.0 + x2 * (-1.0 / 1307674368000.0))))))));
    const double cp = 1.0 + x2 * (-0.5 + x2 * (1.0 / 24 + x2 * (-1.0 / 720 + x2 * (1.0 / 40320 + x2 * (-1.0 / 3628800 + x2 * (1.0 / 479001600.0 + x2 * (-1.0 / 87178291200.0 + x2 * (1.0 / 20922789888000.0))))))));
    if (qi == 0) { s = sp; c = cp; } else if (qi == 1) { s = cp; c = -sp; } else if (qi == 2) { s = -sp; c = -cp; } else { s = -cp; c = sp; }
}

__device__ __forceinline__ void norm_rows(const XSrc src, const float* gain, bf16_t* dbf, float* df32) {
    const int lane = fresh_tid() & 63, gw = fresh_bid() * 8 + (fresh_tid() >> 6), nw = gridDim.x * 8;
    for (int row = gw; row < MROWS; row += 2 * nw) {
        const int row2 = row + nw < MROWS ? row + nw : row;
        const float* xp = src.row(row); const float* xq = src.row(row2);
        f32x4 v[8], u[8]; float ss = 0.f, st = 0.f;
#pragma unroll
        for (int i = 0; i < 8; ++i) { v[i] = *(const f32x4*)(xp + i * 256 + lane * 4); u[i] = *(const f32x4*)(xq + i * 256 + lane * 4); }
#pragma unroll
        for (int i = 0; i < 8; ++i) { ss += v[i][0] * v[i][0] + v[i][1] * v[i][1] + v[i][2] * v[i][2] + v[i][3] * v[i][3]; st += u[i][0] * u[i][0] + u[i][1] * u[i][1] + u[i][2] * u[i][2] + u[i][3] * u[i][3]; }
#pragma unroll
        for (int o = 32; o > 0; o >>= 1) { ss += __shfl_xor(ss, o); st += __shfl_xor(st, o); }
        const float rs = 1.0f / sqrtf(ss * (1.0f / DM) + 1e-6f), rt = 1.0f / sqrtf(st * (1.0f / DM) + 1e-6f);
#pragma unroll
        for (int i = 0; i < 8; ++i) {
            const f32x4 gn = *(const f32x4*)(gain + i * 256 + lane * 4);
            const f32x4 y = v[i] * rs * gn, y2 = u[i] * rt * gn;
            if (dbf) { u32x2 w; w.x = cvt_pk_bf16(y[0], y[1]); w.y = cvt_pk_bf16(y[2], y[3]); *(u32x2*)(dbf + (size_t)row * DM + i * 256 + lane * 4) = w;
                       if (row2 != row) { w.x = cvt_pk_bf16(y2[0], y2[1]); w.y = cvt_pk_bf16(y2[2], y2[3]); *(u32x2*)(dbf + (size_t)row2 * DM + i * 256 + lane * 4) = w; } }
            if (df32) { *(f32x4*)(df32 + (size_t)row * DM + i * 256 + lane * 4) = y; if (row2 != row) *(f32x4*)(df32 + (size_t)row2 * DM + i * 256 + lane * 4) = y2; }
        }
    }
}

__device__ __forceinline__ void phase_prepass(ParamsK p, LAS unsigned char* lds) {
    conv_weights(p, (LAS float*)lds);
    const int gt = fresh_bid() * 512 + fresh_tid(), ngt = gridDim.x * 512;
    for (int i = gt; i < 2049 * 64; i += ngt) {
        const int pidx = i >> 6, fi = i & 63;
        const double inv = exp(-((double)fi / 63.0) * 9.210340371976184);
        const double pos = pidx < SEQ ? (double)pidx : 16384.0;
        double s, c; sincos_d(pos * inv, s, c);
        ((f32x2*)(p->ws + WS_ROT))[i] = (f32x2){(float)c, (float)s};
    }
    for (int i = gt; i < 2 * 64 * 64; i += ngt) {
        const int l = i >> 12, g = (i >> 6) & 63, pp = i & 63;
        const double dt = exp((double)p->in[10][l * 64 + g]);
        const double ar = p->in[8][i], ai = p->in[9][i];
        const double mag = exp(ar * dt); double s, c; sincos_d(ai * dt, s, c);
        const double abr = mag * c, abi = mag * s, den = ar * ar + ai * ai, nr = abr - 1.0, ni = abi;
        const double fr = (nr * ar + ni * ai) / den, fi = (ni * ar - nr * ai) / den;
        double zr = abr, zi = abi;
#pragma unroll 1
        for (int k = 0; k < 6; ++k) { const double t = zr * zr - zi * zi; zi = 2.0 * zr * zi; zr = t; }
        ((f32x4*)(p->ws + WS_S5A))[i] = (f32x4){(float)abr, (float)abi, (float)zr, (float)zi};
        const float* br = p->in[11] + (size_t)i * 16; const float* bi = p->in[12] + (size_t)i * 16;
        f32x2* bo = (f32x2*)(p->ws + WS_S5B) + (size_t)i * 16;
        bf16_t* bmt = (bf16_t*)(p->ws + WS_S5BM) + (size_t)(l * 64 + g) * 2 * 128 * 16;
#pragma unroll 1
        for (int n = 0; n < 16; ++n) { const double b_r = br[n], b_i = bi[n]; const float vr = (float)(fr * b_r - fi * b_i), vi = (float)(fr * b_i + fi * b_r);
            bo[n] = (f32x2){vr, vi}; const bf16_t hr = f2bf(vr), hi = f2bf(vi);
            bmt[pp * 16 + n] = hr; bmt[(64 + pp) * 16 + n] = hi; bmt[2048 + pp * 16 + n] = f2bf(vr - bf2f(hr)); bmt[2048 + (64 + pp) * 16 + n] = f2bf(vi - bf2f(hi)); }
        bf16_t* cm = (bf16_t*)(p->ws + WS_S5C) + (size_t)(l * 64 + g) * 16 * 128;
        const float* cr = p->in[13] + (size_t)(l * 64 + g) * 16 * 64; const float* ci = p->in[14] + (size_t)(l * 64 + g) * 16 * 64;
#pragma unroll 1
        for (int n = 0; n < 16; ++n) { cm[n * 128 + pp] = f2bf(cr[n * 64 + pp]); cm[n * 128 + 64 + pp] = f2bf(-ci[n * 64 + pp]); }
    }
    XSrc x0; x0.a = p->in[0]; x0.b = p->in[1]; x0.split = NPROMPT; x0.valid = MROWS;
    norm_rows(x0, p->in[6], (bf16_t*)(p->ws + WS_XN), nullptr);
}

__device__ __forceinline__ f32x4 mma_lds(f32x4 acc, const LAS bf16_t* A, int lda, const LAS bf16_t* B, int ldb, int K, int lane) {
    const int r = lane & 15, q = lane >> 4;
    const LAS bf16_t* ap = A + r * lda + q * 8; const LAS bf16_t* bp = B + r * ldb + q * 8;
    for (int k = 0; k < K; k += 32) {
        const bf16x8 a = *(const LAS bf16x8*)(ap + k), b = *(const LAS bf16x8*)(bp + k);
        acc = __builtin_amdgcn_mfma_f32_16x16x32_bf16(a, b, acc, 0, 0, 0);
    }
    return acc;
}


__device__ __forceinline__ void phase_gates(ParamsK p, int l) {
    const bf16_t* proj = (const bf16_t*)(p->ws + WS_PROJ);
    float* bcum = (float*)(p->ws + WS_BCUM);
    for (int idx = fresh_bid() * 512 + fresh_tid(); idx < 128 * 512; idx += gridDim.x * 512) {
        const int c = idx >> 9, hk = idx & 511;
        float wg[16];
#pragma unroll
        for (int rr = 0; rr < 16; ++rr) wg[rr] = p->in[19][((size_t)l * 16 + rr) * 512 + hk];
        const float bias = p->in[20][l * 512 + hk];
        float cum = 0.f;
#pragma unroll 4
        for (int t = 0; t < 64; ++t) {
            const size_t row = (size_t)c * 64 + t;
            const u32x4 g0 = *(const u32x4*)(proj + row * NIN + OFF_GLR), g1 = *(const u32x4*)(proj + row * NIN + OFF_GLR + 8);
            float lo = bias;
            lo += bflo(g0.x) * wg[0] + bfhi(g0.x) * wg[1] + bflo(g0.y) * wg[2] + bfhi(g0.y) * wg[3] + bflo(g0.z) * wg[4] + bfhi(g0.z) * wg[5] + bflo(g0.w) * wg[6] + bfhi(g0.w) * wg[7];
            lo += bflo(g1.x) * wg[8] + bfhi(g1.x) * wg[9] + bflo(g1.y) * wg[10] + bfhi(g1.y) * wg[11] + bflo(g1.z) * wg[12] + bfhi(g1.z) * wg[13] + bflo(g1.w) * wg[14] + bfhi(g1.w) * wg[15];
            cum += logsigmoidf_(lo) * 0.0625f;
            bcum[row * 512 + hk] = cum;
        }
    }
}

template <bool RET>
__device__ __forceinline__ void recur_item(ParamsK p, int l, int b, int h, int vs, LAS unsigned char* lds) {
    constexpr int DV = RET ? 128 : 256, NH = RET ? 8 : 4;
    const int tid = fresh_tid(), w = tid >> 6, lane = tid & 63, r = lane & 15, q = lane >> 4;
    LAS float* Bc = (LAS float*)lds;
    LAS bf16_t* Qt = (LAS bf16_t*)(lds + 32768);
    LAS bf16_t* Kt = Qt + 64 * 136;
    LAS bf16_t* KhT = Kt + 64 * 136;
    LAS bf16_t* Vt = KhT + 128 * 72;
    LAS bf16_t* Pm = Vt + 64 * 72;
    LAS bf16_t* St = Pm + 64 * 72;
    LAS float* Gl = (LAS float*)(St + 64 * 136);
    LAS float* Gs = Gl + 64 * 16;
    const bf16_t* proj = (const bf16_t*)(p->ws + WS_PROJ);
    float* oraw = (float*)(p->ws + WS_ORAW);
    const int qcol = (RET ? OFF_RQ : OFF_GQ) + h * 128, kcol = (RET ? OFF_RK : OFF_GK) + h * 128, vcol = (RET ? OFF_RV : OFF_GV) + h * DV + vs * 64;
    const int ocol = (RET ? 1024 + h * 128 : h * 256) + vs * 64;
    for (int i = tid; i < 64 * 136; i += 512) St[i] = 0;
    const float* bcum = (const float*)(p->ws + WS_BCUM) + h * 128;
    const float lg = log1pf(-exp2f(-5.0f - (float)h));
    (void)Bc;
    f32x4 accS[4];
#pragma unroll
    for (int i = 0; i < 4; ++i) accS[i] = (f32x4){0.f, 0.f, 0.f, 0.f};
    u32x4 nq[2], nk[2], nv; f32x4 nb[2][2], nl[2], nd;
    {
        const size_t row0 = (size_t)b * SEQ;
#pragma unroll
        for (int i = 0; i < 2; ++i) { const int idx = tid + i * 512, t = idx >> 4, kv = (idx & 15) * 8;
            nq[i] = *(const u32x4*)(proj + (row0 + t) * NIN + qcol + kv); nk[i] = *(const u32x4*)(proj + (row0 + t) * NIN + kcol + kv); }
        nv = *(const u32x4*)(proj + (row0 + (tid >> 3)) * NIN + vcol + (tid & 7) * 8);
        if (!RET) {
#pragma unroll
            for (int i = 0; i < 2; ++i) { const int idx = tid + i * 512, t = idx >> 4, kv = (idx & 15) * 8; nb[i][0] = *(const f32x4*)(bcum + (row0 + t) * 512 + kv); nb[i][1] = *(const f32x4*)(bcum + (row0 + t) * 512 + kv + 4); }
            { const int kv = (tid & 15) * 8; nl[0] = *(const f32x4*)(bcum + (row0 + 63) * 512 + kv); nl[1] = *(const f32x4*)(bcum + (row0 + 63) * 512 + kv + 4); nd = *(const f32x4*)(bcum + (row0 + 63) * 512 + 16 * w + q * 4); } }
    }
    __syncthreads();
    for (int c = 0; c < 32; ++c) {
        const size_t row0 = (size_t)b * SEQ + c * 64;
#pragma unroll
        for (int i = 0; i < 2; ++i) {
            const int idx = tid + i * 512, t = idx >> 4, kv = (idx & 15) * 8;
            float bb[8], bl[8];
            if (RET) {
#pragma unroll
                for (int j = 0; j < 8; ++j) { bb[j] = (float)(t + 1) * lg; bl[j] = 64.0f * lg; }
            } else {
                const f32x4 b0 = nb[i][0], b1 = nb[i][1], l0 = nl[0], l1 = nl[1];
                bb[0] = b0[0]; bb[1] = b0[1]; bb[2] = b0[2]; bb[3] = b0[3]; bb[4] = b1[0]; bb[5] = b1[1]; bb[6] = b1[2]; bb[7] = b1[3];
                bl[0] = l0[0]; bl[1] = l0[1]; bl[2] = l0[2]; bl[3] = l0[3]; bl[4] = l1[0]; bl[5] = l1[1]; bl[6] = l1[2]; bl[7] = l1[3];
            }
            float qf[8] = {bflo(nq[i].x), bfhi(nq[i].x), bflo(nq[i].y), bfhi(nq[i].y), bflo(nq[i].z), bfhi(nq[i].z), bflo(nq[i].w), bfhi(nq[i].w)};
            float kf[8] = {bflo(nk[i].x), bfhi(nk[i].x), bflo(nk[i].y), bfhi(nk[i].y), bflo(nk[i].z), bfhi(nk[i].z), bflo(nk[i].w), bfhi(nk[i].w)};
            float qt[8], kt[8];
#pragma unroll
            for (int j = 0; j < 8; ++j) { const float em = __expf(-bb[j]); qt[j] = qf[j] * __expf(bb[j]); kt[j] = kf[j] * em; KhT[(kv + j) * 72 + (t ^ (((kv >> 3) & 7) << 3))] = f2bf(kt[j] * __expf(bl[j])); }
            u32x4 wq, wk;
            wq.x = cvt_pk_bf16(qt[0], qt[1]); wq.y = cvt_pk_bf16(qt[2], qt[3]); wq.z = cvt_pk_bf16(qt[4], qt[5]); wq.w = cvt_pk_bf16(qt[6], qt[7]);
            wk.x = cvt_pk_bf16(kt[0], kt[1]); wk.y = cvt_pk_bf16(kt[2], kt[3]); wk.z = cvt_pk_bf16(kt[4], kt[5]); wk.w = cvt_pk_bf16(kt[6], kt[7]);
            *(LAS u32x4*)(Qt + t * 136 + kv) = wq; *(LAS u32x4*)(Kt + t * 136 + kv) = wk;
        }
        { const int t = tid >> 3, vv = (tid & 7) * 8; LAS bf16_t* vp = Vt + vv * 72 + (t ^ (((vv >> 3) & 7) << 3));
            vp[0 * 72] = (bf16_t)(nv.x & 0xffffu); vp[1 * 72] = (bf16_t)(nv.x >> 16); vp[2 * 72] = (bf16_t)(nv.y & 0xffffu); vp[3 * 72] = (bf16_t)(nv.y >> 16);
            vp[4 * 72] = (bf16_t)(nv.z & 0xffffu); vp[5 * 72] = (bf16_t)(nv.z >> 16); vp[6 * 72] = (bf16_t)(nv.w & 0xffffu); vp[7 * 72] = (bf16_t)(nv.w >> 16); }
        const f32x4 dec = RET ? (f32x4){__expf(64.0f * lg), __expf(64.0f * lg), __expf(64.0f * lg), __expf(64.0f * lg)} : (f32x4){__expf(nd[0]), __expf(nd[1]), __expf(nd[2]), __expf(nd[3])};
        if (c + 1 < 32) {
            const size_t rn = row0 + 64;
#pragma unroll
            for (int i = 0; i < 2; ++i) { const int idx = tid + i * 512, t = idx >> 4, kv = (idx & 15) * 8;
                nq[i] = *(const u32x4*)(proj + (rn + t) * NIN + qcol + kv); nk[i] = *(const u32x4*)(proj + (rn + t) * NIN + kcol + kv); }
            nv = *(const u32x4*)(proj + (rn + (tid >> 3)) * NIN + vcol + (tid & 7) * 8);
            if (!RET) {
#pragma unroll
                for (int i = 0; i < 2; ++i) { const int idx = tid + i * 512, t = idx >> 4, kv = (idx & 15) * 8; nb[i][0] = *(const f32x4*)(bcum + (rn + t) * 512 + kv); nb[i][1] = *(const f32x4*)(bcum + (rn + t) * 512 + kv + 4); }
                { const int kv = (tid & 15) * 8; nl[0] = *(const f32x4*)(bcum + (rn + 63) * 512 + kv); nl[1] = *(const f32x4*)(bcum + (rn + 63) * 512 + kv + 4); nd = *(const f32x4*)(bcum + (rn + 63) * 512 + 16 * w + q * 4); } }
        }
        __syncthreads();
        const int tm = w >> 1, vb = w & 1;
#pragma unroll
        for (int s2 = 0; s2 < 2; ++s2) {
            const int sn = (w & 1) * 2 + s2;
            f32x4 sc = mma_lds((f32x4){0.f, 0.f, 0.f, 0.f}, Qt + tm * 16 * 136, 136, Kt + sn * 16 * 136, 136, 128, lane);
#pragma unroll
            for (int j = 0; j < 4; ++j) if (sn > tm || (sn == tm && r > q * 4 + j)) sc[j] = 0.f;
#pragma unroll
            for (int j = 0; j < 4; ++j) Pm[(tm * 16 + q * 4 + j) * 72 + sn * 16 + r] = f2bf(sc[j]);
        }
        f32x4 acco[2];
#pragma unroll
        for (int u = 0; u < 2; ++u) acco[u] = mma_lds((f32x4){0.f, 0.f, 0.f, 0.f}, Qt + tm * 16 * 136, 136, St + (vb + 2 * u) * 16 * 136, 136, 128, lane);
        __syncthreads();
#pragma unroll
        for (int u = 0; u < 2; ++u) {
            { const int vt = vb + 2 * u, swv = ((2 * vt + (r >> 3)) & 7) << 3; const LAS bf16_t* pp = Pm + (tm * 16 + r) * 72 + q * 8; const LAS bf16_t* vr = Vt + (vt * 16 + r) * 72;
              acco[u] = __builtin_amdgcn_mfma_f32_16x16x32_bf16(*(const LAS bf16x8*)pp, *(const LAS bf16x8*)(vr + ((q * 8) ^ swv)), acco[u], 0, 0, 0);
              acco[u] = __builtin_amdgcn_mfma_f32_16x16x32_bf16(*(const LAS bf16x8*)(pp + 32), *(const LAS bf16x8*)(vr + ((32 + q * 8) ^ swv)), acco[u], 0, 0, 0); }
#pragma unroll
            for (int j = 0; j < 4; ++j) oraw[(row0 + tm * 16 + q * 4 + j) * DM + ocol + (vb + 2 * u) * 16 + r] = acco[u][j];
        }
        {
            const int swk = ((2 * w + (r >> 3)) & 7) << 3;
            const bf16x8 ka0 = *(const LAS bf16x8*)(KhT + (16 * w + r) * 72 + ((q * 8) ^ swk)), ka1 = *(const LAS bf16x8*)(KhT + (16 * w + r) * 72 + ((32 + q * 8) ^ swk));
#pragma unroll
            for (int v2 = 0; v2 < 4; ++v2) {
                accS[v2] = accS[v2] * dec;
                { const int swv = ((2 * v2 + (r >> 3)) & 7) << 3; const LAS bf16_t* vr = Vt + (v2 * 16 + r) * 72;
                  accS[v2] = __builtin_amdgcn_mfma_f32_16x16x32_bf16(ka0, *(const LAS bf16x8*)(vr + ((q * 8) ^ swv)), accS[v2], 0, 0, 0);
                  accS[v2] = __builtin_amdgcn_mfma_f32_16x16x32_bf16(ka1, *(const LAS bf16x8*)(vr + ((32 + q * 8) ^ swv)), accS[v2], 0, 0, 0); }
                u32x2 ws; ws.x = cvt_pk_bf16(accS[v2][0], accS[v2][1]); ws.y = cvt_pk_bf16(accS[v2][2], accS[v2][3]);
                *(LAS u32x2*)(St + (v2 * 16 + r) * 136 + 16 * w + q * 4) = ws;
            }
        }
        __syncthreads();
    }
    float* so = p->out + (RET ? O_PRET : O_PGLA) + ((size_t)(l * NB + b) * NH + h) * 128 * DV;
#pragma unroll
    for (int v2 = 0; v2 < 4; ++v2)
#pragma unroll
        for (int j = 0; j < 4; ++j) so[(size_t)(16 * w + q * 4 + j) * DV + vs * 64 + v2 * 16 + r] = accS[v2][j];
    __syncthreads();
}

__device__ __forceinline__ void s5_prompt_item(ParamsK p, int l, int b, int g, LAS unsigned char* lds) {
    const int tid = fresh_tid(), w = tid >> 6, lane = tid & 63, r = lane & 15, q = lane >> 4;
    LAS f32x2* F = (LAS f32x2*)lds;
    LAS f32x2* Ss = F;
    LAS float* Bu = (LAS float*)(lds + 16384 + w * 12800);
    LAS bf16_t* Xw = (LAS bf16_t*)(lds + 16384 + w * 12800 + 8448);
    const bf16_t* proj = (const bf16_t*)(p->ws + WS_PROJ);
    bf16_t* y5g = (bf16_t*)(p->ws + WS_Y5G);
    const int lg = l * 64 + g;
    const f32x4 av = ((const f32x4*)(p->ws + WS_S5A))[lg * 64 + lane];
    const float abr = av[0], abi = av[1];
    bf16x8 bm[8];
    { const bf16_t* bmt = (const bf16_t*)(p->ws + WS_S5BM) + (size_t)lg * 2 * 128 * 16;
#pragma unroll
      for (int i = 0; i < 8; ++i) bm[i] = *(const bf16x8*)(bmt + (q >> 1) * 2048 + (i * 16 + r) * 16 + (q & 1) * 8); }
    const bf16_t* ubase = proj + ((size_t)b * SEQ + r) * NIN + OFF_U + g * 16 + (q & 1) * 8;
#define S5_UADDR(blk) (ubase + (size_t)((w + 8 * ((blk) >> 2)) * 64 + ((blk) & 3) * 16) * NIN)
#define S5_BLOCK(ub) do { \
        _Pragma("unroll") for (int i = 0; i < 8; ++i) { const f32x4 a4 = __builtin_amdgcn_mfma_f32_16x16x32_bf16(bm[i], ub, (f32x4){0.f, 0.f, 0.f, 0.f}, 0, 0, 0); *(LAS f32x4*)(Bu + r * 132 + i * 16 + q * 4) = a4; } \
        asm volatile("s_waitcnt lgkmcnt(0)" ::: "memory"); } while (0)
#define S5_STEP(t) do { const float bur = Bu[(t) * 132 + lane], bui = Bu[(t) * 132 + 64 + lane]; \
        const float nxr = abr * x[0] - abi * x[1] + bur, nxi = abr * x[1] + abi * x[0] + bui; x[0] = nxr; x[1] = nxi; } while (0)
    bf16x8 ubn = *(const bf16x8*)S5_UADDR(0);
    for (int ci = 0; ci < 4; ++ci) {
        const int c = w + 8 * ci;
        f32x2 x = (f32x2){0.f, 0.f};
        for (int tb = 0; tb < 4; ++tb) {
            const int blk = ci * 4 + tb; const bf16x8 ubc = ubn;
            if (blk + 1 < 16) ubn = *(const bf16x8*)S5_UADDR(blk + 1);
            S5_BLOCK(ubc);
#pragma unroll
            for (int tt = 0; tt < 16; ++tt) S5_STEP(tt);
            asm volatile("s_waitcnt lgkmcnt(0)" ::: "memory");
        }
        F[c * 64 + lane] = x;
    }
    __syncthreads();
    if (w == 0) {
        const float a64r = av[2], a64i = av[3];
        f32x2 s = (f32x2){0.f, 0.f};
        for (int c = 0; c < 32; ++c) { const f32x2 f = F[c * 64 + lane]; Ss[c * 64 + lane] = s;
            const float nr = a64r * s[0] - a64i * s[1] + f[0], ni = a64r * s[1] + a64i * s[0] + f[1]; s[0] = nr; s[1] = ni; }
        p->out[O_PS5R + (size_t)((l * NB + b) * 64 + g) * 64 + lane] = s[0];
        p->out[O_PS5I + (size_t)((l * NB + b) * 64 + g) * 64 + lane] = s[1];
    }
    __syncthreads();
    bf16x8 cmf[4];
    { const bf16_t* cm = (const bf16_t*)(p->ws + WS_S5C) + (size_t)lg * 16 * 128 + r * 128 + q * 8;
#pragma unroll
      for (int ks = 0; ks < 4; ++ks) cmf[ks] = *(const bf16x8*)(cm + ks * 32); }
    const float dsk = p->in[15][l * 1024 + g * 16 + r];
    ubn = *(const bf16x8*)S5_UADDR(0);
    for (int ci = 0; ci < 4; ++ci) {
        const int c = w + 8 * ci;
        f32x2 x = Ss[c * 64 + lane];
        for (int tb = 0; tb < 4; ++tb) {
            const int blk = ci * 4 + tb; const bf16x8 ubc = ubn;
            if (blk + 1 < 16) ubn = *(const bf16x8*)S5_UADDR(blk + 1);
            bf16_t du[4];
#pragma unroll
            for (int j = 0; j < 4; ++j) du[j] = proj[((size_t)b * SEQ + c * 64 + tb * 16 + q * 4 + j) * NIN + OFF_U + g * 16 + r];
            S5_BLOCK(ubc);
#pragma unroll
            for (int tt = 0; tt < 16; ++tt) { S5_STEP(tt); Xw[tt * 136 + lane] = f2bf(x[0]); Xw[tt * 136 + 64 + lane] = f2bf(x[1]); }
            asm volatile("s_waitcnt lgkmcnt(0)" ::: "memory");
            f32x4 acc = (f32x4){0.f, 0.f, 0.f, 0.f};
#pragma unroll
            for (int ks = 0; ks < 4; ++ks) { const bf16x8 a = *(const LAS bf16x8*)(Xw + r * 136 + ks * 32 + q * 8); acc = __builtin_amdgcn_mfma_f32_16x16x32_bf16(a, cmf[ks], acc, 0, 0, 0); }
#pragma unroll
            for (int j = 0; j < 4; ++j) { const int t = tb * 16 + q * 4 + j; const size_t row = (size_t)b * SEQ + c * 64 + t;
                const float y = acc[j] + dsk * bf2f(du[j]);
                y5g[row * 1024 + g * 16 + r] = f2bf(geluf_(y)); }
            asm volatile("s_waitcnt lgkmcnt(0)" ::: "memory");
        }
    }
#undef S5_BLOCK
#undef S5_UADDR
#undef S5_STEP
    __syncthreads();
}

__device__ __forceinline__ void s5_sample(ParamsK p, int l, LAS unsigned char* lds, int wg0, int nwg) {
    const int tid = fresh_tid(), w = tid >> 6, lane = tid & 63, r = lane & 15, q = lane >> 4;
    LAS float* xs = (LAS float*)(lds + w * 512);
    const bf16_t* proj = (const bf16_t*)(p->ws + WS_PROJ);
    bf16_t* y5g = (bf16_t*)(p->ws + WS_Y5G);
    for (int item = (fresh_bid() - wg0) * 8 + w; item < NSAMP * 64; item += nwg * 8) {
        const int b = item >> 6, g = item & 63, lg = l * 64 + g;
        const size_t row = NPROMPT + b;
        const f32x4 av = ((const f32x4*)(p->ws + WS_S5A))[lg * 64 + lane];
        const u32x4 u0 = *(const u32x4*)(proj + row * NIN + OFF_U + g * 16), u1 = *(const u32x4*)(proj + row * NIN + OFF_U + g * 16 + 8);
        const float u[16] = {bflo(u0.x), bfhi(u0.x), bflo(u0.y), bfhi(u0.y), bflo(u0.z), bfhi(u0.z), bflo(u0.w), bfhi(u0.w), bflo(u1.x), bfhi(u1.x), bflo(u1.y), bfhi(u1.y), bflo(u1.z), bfhi(u1.z), bflo(u1.w), bfhi(u1.w)};
        const size_t si = ((size_t)(l * NSAMP + b) * 64 + g) * 64 + lane;
        const float x0r = p->in[2][si], x0i = p->in[3][si];
        float xr = av[0] * x0r - av[1] * x0i, xi = av[0] * x0i + av[1] * x0r;
        const f32x4* bp = (const f32x4*)((const f32x2*)(p->ws + WS_S5B) + (size_t)(lg * 64 + lane) * 16);
#pragma unroll
        for (int i = 0; i < 8; ++i) { const f32x4 t = bp[i]; xr += t[0] * u[2 * i] + t[2] * u[2 * i + 1]; xi += t[1] * u[2 * i] + t[3] * u[2 * i + 1]; }
        p->out[O_SS5R + si] = xr; p->out[O_SS5I + si] = xi;
        xs[lane] = xr; xs[64 + lane] = xi;
        asm volatile("s_waitcnt lgkmcnt(0)" ::: "memory");
        const float* cr = p->in[13] + ((size_t)lg * 16 + r) * 64 + q * 16; const float* ci = p->in[14] + ((size_t)lg * 16 + r) * 64 + q * 16;
        float y = 0.f;
#pragma unroll
        for (int i = 0; i < 4; ++i) { const f32x4 a = *(const f32x4*)(cr + 4 * i), c2 = *(const f32x4*)(ci + 4 * i);
            const f32x4 vr = *(const LAS f32x4*)(xs + q * 16 + 4 * i), vi = *(const LAS f32x4*)(xs + 64 + q * 16 + 4 * i);
            y += a[0] * vr[0] + a[1] * vr[1] + a[2] * vr[2] + a[3] * vr[3] - (c2[0] * vi[0] + c2[1] * vi[1] + c2[2] * vi[2] + c2[3] * vi[3]); }
        y += __shfl_xor(y, 16); y += __shfl_xor(y, 32);
        float ur = 0.f;
#pragma unroll
        for (int i = 0; i < 16; ++i) ur = (r == i) ? u[i] : ur;
        y += p->in[15][l * 1024 + g * 16 + r] * ur;
        if (q == 0) y5g[row * 1024 + g * 16 + r] = f2bf(geluf_(y));
        asm volatile("s_waitcnt lgkmcnt(0)" ::: "memory");
    }
    __syncthreads();
}

template <bool RET>
__device__ __forceinline__ void recur_sample_item(ParamsK p, int l, int item, LAS unsigned char* lds) {
    constexpr int DV = RET ? 128 : 256, NH = RET ? 8 : 4, NV4 = DV / 4, KR = 512 / NV4;
    const int tid = fresh_tid();
    LAS float* qs = (LAS float*)lds; LAS float* ks = qs + 128; LAS float* ds = ks + 128; LAS float* red = ds + 128;
    const bf16_t* proj = (const bf16_t*)(p->ws + WS_PROJ);
    float* oraw = (float*)(p->ws + WS_ORAW);
    const int b = item / NH, h = item % NH;
    const size_t row = NPROMPT + b;
    if (tid < 128) {
        qs[tid] = bf2f(proj[row * NIN + (RET ? OFF_RQ : OFF_GQ) + h * 128 + tid]);
        ks[tid] = bf2f(proj[row * NIN + (RET ? OFF_RK : OFF_GK) + h * 128 + tid]);
        float dec;
        if (RET) dec = 1.0f - exp2f(-5.0f - (float)h);
        else { float lo = p->in[20][l * 512 + h * 128 + tid];
#pragma unroll
            for (int rr = 0; rr < 16; ++rr) lo += bf2f(proj[row * NIN + OFF_GLR + rr]) * p->in[19][((size_t)l * 16 + rr) * 512 + h * 128 + tid];
            dec = __expf(logsigmoidf_(lo) * 0.0625f); }
        ds[tid] = dec;
    }
    __syncthreads();
    const int vq = tid % NV4, kr = tid / NV4;
    const u32x2 vb = *(const u32x2*)(proj + row * NIN + (RET ? OFF_RV : OFF_GV) + h * DV + vq * 4);
    const f32x4 v4 = (f32x4){bflo(vb.x), bfhi(vb.x), bflo(vb.y), bfhi(vb.y)};
    const size_t sbase = ((size_t)(l * NSAMP + b) * NH + h) * 128 * DV;
    const float* s0 = p->in[RET ? 5 : 4] + sbase; float* sn = p->out + (RET ? O_SRET : O_SGLA) + sbase;
    f32x4 o4 = (f32x4){0.f, 0.f, 0.f, 0.f};
#pragma unroll 8
    for (int k = kr; k < 128; k += KR) {
        const f32x4 s = __builtin_nontemporal_load((const f32x4*)(s0 + (size_t)k * DV + vq * 4));
        const f32x4 nw = s * ds[k] + v4 * ks[k];
        __builtin_nontemporal_store(nw, (f32x4*)(sn + (size_t)k * DV + vq * 4));
        o4 += nw * qs[k];
    }
    *(LAS f32x4*)(red + kr * DV + vq * 4) = o4;
    __syncthreads();
    if (tid < DV) { float o = 0.f;
#pragma unroll
        for (int i = 0; i < KR; ++i) o += red[i * DV + tid];
        oraw[row * DM + (RET ? 1024 + h * 128 : h * 256) + tid] = o; }
    __syncthreads();
}

__device__ __forceinline__ void phase_mixers(ParamsK p, int l, LAS unsigned char* lds) {
    const int bid = fresh_bid(), G = gridDim.x, half = G >> 1;
    if (bid < half) {
        for (int item = bid; item < 128; item += half) {
            if (item < 64) recur_item<false>(p, l, item >> 4, (item >> 2) & 3, item & 3, lds);
            else { const int it = item - 64; recur_item<true>(p, l, it >> 4, (it >> 1) & 7, it & 1, lds); }
        }
    } else {
        for (int rep = 0; rep < REP_S5; ++rep) for (int item = bid - half; item < 256; item += G - half) s5_prompt_item(p, l, item >> 6, item & 63, lds);
        s5_sample(p, l, lds, half, G - half);
    }
    unsigned* ctr = (unsigned*)(p->ws + WS_BAR) + 3584 + 64 * l;
    LAS int* slot = (LAS int*)(lds + 65536);
    for (;;) {
        if (fresh_tid() == 0) slot[0] = (int)__hip_atomic_fetch_add(ctr, 1u, __ATOMIC_RELAXED, __HIP_MEMORY_SCOPE_AGENT);
        __syncthreads();
        const int item = slot[0];
        __syncthreads();
        if (item >= 1536) break;
        if (item < 512) recur_sample_item<false>(p, l, item, lds); else recur_sample_item<true>(p, l, item - 512, lds);
    }
}

__device__ __forceinline__ void post_norms(ParamsK p, int l) {
    const int tid = fresh_tid();
    const float* oraw = (const float*)(p->ws + WS_ORAW);
    const bf16_t* proj = (const bf16_t*)(p->ws + WS_PROJ);
    bf16_t* agla = (bf16_t*)(p->ws + WS_AGLA); bf16_t* aret = (bf16_t*)(p->ws + WS_ARET);
    const bool gla = tid < 256;
    const int col = gla ? tid * 4 : (tid - 256) * 4;
    f32x4 gn = (f32x4){1.f, 1.f, 1.f, 1.f};
    if (gla) gn = *(const f32x4*)(p->in[21] + l * 256 + (col & 255));
    const int bid = fresh_bid();
    if (bid >= 132 && bid < 231) return;
    const int widx = bid < 132 ? bid : bid - 99;
    const int G = (int)gridDim.x - 99;
    for (int row0 = widx; row0 < MROWS; row0 += 4 * G) {
        f32x4 o[4]; u32x2 gb[4];
#pragma unroll
        for (int u = 0; u < 4; ++u) { const int row = row0 + u * G < MROWS ? row0 + u * G : row0;
            o[u] = *(const f32x4*)(oraw + (size_t)row * DM + tid * 4); gb[u] = *(const u32x2*)(proj + (size_t)row * NIN + (gla ? OFF_GR : OFF_RG) + col); }
#pragma unroll
        for (int u = 0; u < 4; ++u) {
            const int row = row0 + u * G; if (row >= MROWS) break;
            u32x2 w;
            if (gla) {
                float ss = o[u][0] * o[u][0] + o[u][1] * o[u][1] + o[u][2] * o[u][2] + o[u][3] * o[u][3];
#pragma unroll
                for (int s2 = 32; s2 > 0; s2 >>= 1) ss += __shfl_xor(ss, s2);
                const float rs = 1.0f / sqrtf(ss * (1.0f / 256.0f) + 1e-6f);
                w.x = cvt_pk_bf16(o[u][0] * rs * gn[0] * bflo(gb[u].x), o[u][1] * rs * gn[1] * bfhi(gb[u].x)); w.y = cvt_pk_bf16(o[u][2] * rs * gn[2] * bflo(gb[u].y), o[u][3] * rs * gn[3] * bfhi(gb[u].y));
                *(u32x2*)(agla + (size_t)row * 1024 + col) = w;
            } else {
                float sm = o[u][0] + o[u][1] + o[u][2] + o[u][3];
#pragma unroll
                for (int s2 = 16; s2 > 0; s2 >>= 1) sm += __shfl_xor(sm, s2);
                const float mu = sm * (1.0f / 128.0f);
                const f32x4 d = o[u] - mu;
                float ss = d[0] * d[0] + d[1] * d[1] + d[2] * d[2] + d[3] * d[3];
#pragma unroll
                for (int s2 = 16; s2 > 0; s2 >>= 1) ss += __shfl_xor(ss, s2);
                const float rs = 1.0f / sqrtf(ss * (1.0f / 128.0f) + 1e-6f);
                w.x = cvt_pk_bf16(d[0] * rs * bflo(gb[u].x), d[1] * rs * bfhi(gb[u].x)); w.y = cvt_pk_bf16(d[2] * rs * bflo(gb[u].y), d[3] * rs * bfhi(gb[u].y));
                *(u32x2*)(aret + (size_t)row * 1024 + col) = w;
            }
        }
    }
}


__device__ __forceinline__ void skinny_resid(const bf16_t* A, int lda, const bf16_t* Wt, int ldb, int K, const XSrc res, float* out, LAS unsigned char* lds) {
    const int tid = fresh_tid(), w = tid >> 6, lane = tid & 63, r = lane & 15, q = lane >> 4;
    LAS float* red = (LAS float*)lds;
    for (int piece = fresh_bid(); piece < 256; piece += gridDim.x) {
        const int rh = piece & 1, cg = piece >> 1;
        const bf16_t* ap = A + (size_t)(NPROMPT + rh * 64 + r) * lda + q * 8;
        const bf16_t* bp = Wt + (size_t)(cg * 16 + r) * ldb + q * 8;
        const int ksper = K / 256, k0 = w * ksper * 32;
        f32x4 acc[4];
#pragma unroll
        for (int mt = 0; mt < 4; ++mt) acc[mt] = (f32x4){0.f, 0.f, 0.f, 0.f};
#pragma unroll 4
        for (int ks = 0; ks < ksper; ++ks) {
            const int k = k0 + ks * 32;
            const bf16x8 b = *(const bf16x8*)(bp + k);
            bf16x8 a[4];
#pragma unroll
            for (int mt = 0; mt < 4; ++mt) a[mt] = *(const bf16x8*)(ap + (size_t)mt * 16 * lda + k);
#pragma unroll
            for (int mt = 0; mt < 4; ++mt) acc[mt] = __builtin_amdgcn_mfma_f32_16x16x32_bf16(a[mt], b, acc[mt], 0, 0, 0);
        }
#pragma unroll
        for (int mt = 0; mt < 4; ++mt) *(LAS f32x4*)(red + w * 1024 + (mt * 64 + lane) * 4) = acc[mt];
        __syncthreads();
#pragma unroll
        for (int h = 0; h < 2; ++h) {
            const int e = tid + h * 512;
            float sum = 0.f;
#pragma unroll
            for (int ww = 0; ww < 8; ++ww) sum += red[ww * 1024 + e];
            const int mt = e >> 8, ln = (e >> 2) & 63, j = e & 3;
            const int row = NPROMPT + rh * 64 + mt * 16 + (ln >> 4) * 4 + j, col = cg * 16 + (ln & 15);
            out[(size_t)row * DM + col] = res.row(row)[col] + sum;
        }
        __syncthreads();
    }
}


__device__ __forceinline__ void skinny_merge(ParamsK p, int l, LAS unsigned char* lds) {
    const int tid = fresh_tid(), w = tid >> 6, lane = tid & 63, r = lane & 15, q = lane >> 4;
    LAS float* red = (LAS float*)lds;
    const bf16_t* proj = (const bf16_t*)(p->ws + WS_PROJ); bf16_t* O = (bf16_t*)(p->ws + WS_MERGED);
    for (int piece = fresh_bid(); piece < 256; piece += gridDim.x) {
        const int rh = piece & 1, cg = piece >> 1;
#pragma unroll
        for (int z = 0; z < 3; ++z) {
            const bf16_t* A = (const bf16_t*)(p->ws + (z == 0 ? WS_AS5 : (z == 1 ? WS_AGLA : WS_ARET)));
            const bf16_t* Wt = (const bf16_t*)(p->ws + (z == 0 ? WS_WS5O : (z == 1 ? WS_WGLAO : WS_WRETO)) + l * SZ_WBR);
            const bf16_t* ap = A + (size_t)(NPROMPT + rh * 64 + r) * 1024 + q * 8 + w * 128;
            const bf16_t* bp = Wt + (size_t)(cg * 16 + r) * 1024 + q * 8 + w * 128;
            f32x4 acc[4];
#pragma unroll
            for (int mt = 0; mt < 4; ++mt) acc[mt] = (f32x4){0.f, 0.f, 0.f, 0.f};
#pragma unroll
            for (int ks = 0; ks < 4; ++ks) {
                const bf16x8 b = *(const bf16x8*)(bp + ks * 32);
#pragma unroll
                for (int mt = 0; mt < 4; ++mt) { const bf16x8 a = *(const bf16x8*)(ap + (size_t)mt * 16 * 1024 + ks * 32); acc[mt] = __builtin_amdgcn_mfma_f32_16x16x32_bf16(a, b, acc[mt], 0, 0, 0); }
            }
#pragma unroll
            for (int mt = 0; mt < 4; ++mt) *(LAS f32x4*)(red + (z * 8 + w) * 1024 + (mt * 64 + lane) * 4) = acc[mt];
        }
        __syncthreads();
#pragma unroll
        for (int h = 0; h < 2; ++h) {
            const int e = tid + h * 512;
            const int mt = e >> 8, ln = (e >> 2) & 63, j = e & 3;
            const int row = NPROMPT + rh * 64 + mt * 16 + (ln >> 4) * 4 + j, col = cg * 16 + (ln & 15);
            float tot = 0.f;
#pragma unroll
            for (int z = 0; z < 3; ++z) { float sum = 0.f;
#pragma unroll
                for (int ww = 0; ww < 8; ++ww) sum += red[(z * 8 + ww) * 1024 + e];
                tot += sum * bf2f(proj[(size_t)row * NIN + OFF_MG + z * 2048 + col]); }
            O[(size_t)row * DM + col] = f2bf(tot);
        }
        __syncthreads();
    }
}

#define XB_TMO      128
#define XB_XCNT(j)  (256  + 64 * (j))
#define XB_XSUB(j)  (1280 + 64 * (j))
#define XB_XGEN(j)  (2304 + 64 * (j))
#define XB_TOP      3328
#define XB_TOPGEN   3392
#define XCD_BAR_WORDS 3456
#define XB_SPIN_CAP (1u << 18)
__device__ __forceinline__ unsigned xb_ld(unsigned* p)              { return __hip_atomic_load(p, __ATOMIC_RELAXED, __HIP_MEMORY_SCOPE_AGENT); }
__device__ __forceinline__ unsigned xb_add(unsigned* p, unsigned v) { return __hip_atomic_fetch_add(p, v, __ATOMIC_RELAXED, __HIP_MEMORY_SCOPE_AGENT); }
__device__ __forceinline__ unsigned xb_xcc_id() { return (unsigned)__builtin_amdgcn_s_getreg((3 << 11) | 20) & 0xFu; }
#define XB_SPIN(cond, bar) do { unsigned _sp = 0; while (cond) { __builtin_amdgcn_s_sleep(1); \
    if ((++_sp & 255u) == 0u) { if (xb_ld(&(bar)[XB_TMO])) break; if (_sp > XB_SPIN_CAP) { atomicAdd(&(bar)[XB_TMO], 1u); break; } } } } while (0)
struct XcdBarrier { unsigned* bar; unsigned x; volatile LAS unsigned* st; };
__device__ __forceinline__ XcdBarrier xcd_barrier_post(unsigned* bar, volatile LAS unsigned* st) {
    XcdBarrier b; b.bar = bar; b.x = xb_xcc_id(); b.st = st;
    if (threadIdx.x == 0) (void)xb_add(&bar[XB_XCNT(b.x)], 1u);
    return b;
}
__device__ __forceinline__ void xcd_barrier_complete(unsigned* bar, unsigned x, unsigned& nloc, unsigned& nx) {
    const unsigned G = gridDim.x * gridDim.y * gridDim.z;
    unsigned sum, cnt, mine, sp = 0u;
    for (;;) {
        sum = 0u; cnt = 0u; mine = 0u;
#pragma unroll
        for (unsigned j = 0; j < 16; ++j) { const unsigned c = xb_ld(&bar[XB_XCNT(j)]); sum += c; cnt += (c > 0u) ? 1u : 0u; mine = (j == x) ? c : mine; }
        if (sum == G) break;
        __builtin_amdgcn_s_sleep(1);
        if ((++sp & 255u) == 0u) { if (xb_ld(&bar[XB_TMO])) break; if (sp > XB_SPIN_CAP) { atomicAdd(&bar[XB_TMO], 1u); break; } }
    }
    nloc = mine > 0u ? mine : 1u; nx = cnt > 0u ? cnt : 1u;
}
__device__ __forceinline__ void xcd_barrier(const XcdBarrier& b) {
    asm volatile("s_waitcnt vmcnt(0)" ::: "memory");
    __syncthreads();
    if (threadIdx.x == 0) {
        unsigned* bar = b.bar;
        __builtin_amdgcn_s_waitcnt(0);
        unsigned nloc = b.st[0], nx = b.st[1];
        if (nloc == 0u) { xcd_barrier_complete(bar, b.x, nloc, nx); b.st[0] = nloc; b.st[1] = nx; }
        const unsigned old = xb_add(&bar[XB_XSUB(b.x)], 1u);
        const unsigned gen = old / nloc;
        if (old + 1u == (gen + 1u) * nloc) {
            __builtin_amdgcn_fence(__ATOMIC_RELEASE, "agent");
            asm volatile("s_waitcnt vmcnt(0)" ::: "memory");
            const unsigned og = xb_add(&bar[XB_TOP], 1u);
            const unsigned tg = og / nx;
            if (og + 1u == (tg + 1u) * nx) xb_add(&bar[XB_TOPGEN], 1u);
            else XB_SPIN(xb_ld(&bar[XB_TOPGEN]) == tg, bar);
            __builtin_amdgcn_fence(__ATOMIC_ACQUIRE, "agent");
            xb_add(&bar[XB_XGEN(b.x)], 1u);
            asm volatile("s_waitcnt vmcnt(0)" ::: "memory");
        } else {
            XB_SPIN(xb_ld(&bar[XB_XGEN(b.x)]) == gen, bar);
            __builtin_amdgcn_fence(__ATOMIC_ACQUIRE, "agent");
            asm volatile("s_waitcnt vmcnt(0)" ::: "memory");
        }
    }
    __syncthreads();
}
#define GSYNC() do { XcdBarrier _b; _b.bar = (unsigned*)(fresh_params()->ws + WS_BAR); _b.x = xb_xcc_id(); _b.st = (volatile LAS unsigned*)(lds + 131072); xcd_barrier(_b); } while (0)

__global__ void __launch_bounds__(512) hybrid_fwd(Params p_unused) {
    extern __shared__ __attribute__((aligned(16))) unsigned char lds_raw[];
    LAS unsigned char* lds = (LAS unsigned char*)lds_raw;
    cg::grid_group grid = cg::this_grid();
    const int G = gridDim.x;

    if (threadIdx.x < 4) ((volatile LAS unsigned*)(lds + 131072))[threadIdx.x] = 0u;
    __syncthreads();
    (void)xcd_barrier_post((unsigned*)(fresh_params()->ws + WS_BAR), (volatile LAS unsigned*)(lds + 131072));
    for (int rep = 0; rep < REP_PRE; ++rep) phase_prepass(fresh_params(), lds);
    if (fresh_params()->ws == nullptr) grid.sync();
    GSYNC();
    for (int rep = 0; rep < REP_SYNC; ++rep) GSYNC();
#pragma unroll 1
    for (int l = 0; l < 2; ++l) {
        {
            ParamsK p = fresh_params();
            pg8::Gemm g; g.A0 = g.A1 = g.A2 = (const bf16_t*)(p->ws + WS_XN); g.B0 = g.B1 = g.B2 = (const bf16_t*)(p->ws + WS_WIN + l * SZ_WIN); g.lda = 2048; g.ldb = 2048; g.K = 2048;
            pg8::TileOrder S; S.init(MP, 54 * 256, G, fresh_bid(), 1); S.cut = 53; S.shift = 3;
            EpiInProj E; E.O = (bf16_t*)(p->ws + WS_PROJ); E.rot = (const float*)(p->ws + WS_ROT);
            for (int rep = 0; rep < REP_INPROJ; ++rep) pg8::gemm_phase(lds, g, S, E);
        }
        GSYNC();
        phase_gates(fresh_params(), l);
        GSYNC();
        for (int rep = 0; rep < REP_MIX; ++rep) phase_mixers(fresh_params(), l, lds);
        GSYNC();
        {
            ParamsK p = fresh_params();
            pg8::Gemm g; g.A0 = g.A1 = g.A2 = (const bf16_t*)(p->ws + WS_Y5G); g.B0 = g.B1 = g.B2 = (const bf16_t*)(p->ws + WS_WGLU + l * SZ_WGLU); g.lda = 1024; g.ldb = 1024; g.K = 1024;
            pg8::TileOrder S; S.init(MP, 1024, G, fresh_bid(), 1);
            EpiGlu E; E.O = (bf16_t*)(p->ws + WS_AS5); E.Y = (const bf16_t*)(p->ws + WS_Y5G); E.bias = p->in[17] + l * 1024;
            for (int rep = 0; rep < REP_POST; ++rep) { pg8::gemm_phase(lds, g, S, E);
            {
                ParamsK p2 = fresh_params();
                pg8::Gemm g2; g2.A0 = g2.A1 = g2.A2 = (const bf16_t*)(p2->ws + WS_XN); g2.B0 = g2.B1 = g2.B2 = (const bf16_t*)(p2->ws + WS_WIN + l * SZ_WIN); g2.lda = 2048; g2.ldb = 2048; g2.K = 2048;
                const int c2 = fresh_bid() - 132;
                if (c2 >= 0) {
                    pg8::TileOrder S2; S2.init(MP, 3 * 256, (int)gridDim.x - 132, c2, 1); S2.cut = 0; S2.shift = 53;
                    EpiInProj E2; E2.O = (bf16_t*)(p2->ws + WS_PROJ); E2.rot = (const float*)(p2->ws + WS_ROT);
                    pg8::gemm_phase(lds, g2, S2, E2);
                }
            }
            post_norms(fresh_params(), l); }
        }
        GSYNC();
        {
            ParamsK p = fresh_params();
            pg8::Gemm g; g.A0 = (const bf16_t*)(p->ws + WS_AS5); g.A1 = (const bf16_t*)(p->ws + WS_AGLA); g.A2 = (const bf16_t*)(p->ws + WS_ARET);
            g.B0 = (const bf16_t*)(p->ws + WS_WS5O + l * SZ_WBR); g.B1 = (const bf16_t*)(p->ws + WS_WGLAO + l * SZ_WBR); g.B2 = (const bf16_t*)(p->ws + WS_WRETO + l * SZ_WBR);
            g.lda = 1024; g.ldb = 1024; g.K = 1024;
            pg8::TileOrder S; S.init(NPROMPT, DM, G, fresh_bid(), 3);
            EpiMerge E; E.O = (bf16_t*)(p->ws + WS_MERGED); E.proj = (const bf16_t*)(p->ws + WS_PROJ);
            for (int rep = 0; rep < REP_MG; ++rep) { pg8::gemm_phase(lds, g, S, E); skinny_merge(fresh_params(), l, lds); }
        }
        GSYNC();
        {
            ParamsK p = fresh_params();
            pg8::Gemm g; g.A0 = g.A1 = g.A2 = (const bf16_t*)(p->ws + WS_MERGED); g.B0 = g.B1 = g.B2 = (const bf16_t*)(p->ws + WS_WMIX + l * SZ_WMIX); g.lda = 2048; g.ldb = 2048; g.K = 2048;
            pg8::TileOrder S; S.init(NPROMPT, DM, G, fresh_bid(), 1);
            EpiResid E; E.O = (float*)(p->ws + WS_X1); E.zero = (DBG_ZMASK >> 4) & 1;
            const float* X2 = (const float*)(p->ws + WS_X2);
            if (l == 0) { E.res.a = p->in[0]; E.res.b = p->in[1]; E.res.split = NPROMPT; E.res.valid = MROWS; } else { E.res.a = X2; E.res.b = X2; E.res.split = MP; E.res.valid = MP; }
            for (int rep = 0; rep < REP_MO; ++rep) { pg8::gemm_phase(lds, g, S, E);
                skinny_resid((const bf16_t*)(p->ws + WS_MERGED), 2048, (const bf16_t*)(p->ws + WS_WMIX + l * SZ_WMIX), 2048, 2048, E.res, E.O, lds); }
        }
        GSYNC();
        { ParamsK p = fresh_params(); const float* X1 = (const float*)(p->ws + WS_X1); XSrc s; s.a = X1; s.b = X1; s.split = MP; s.valid = MP; for (int rep = 0; rep < REP_NORM; ++rep) norm_rows(s, p->in[25] + l * DM, (bf16_t*)(p->ws + WS_XN), nullptr); }
        GSYNC();
        {
            ParamsK p = fresh_params();
            pg8::Gemm g; g.A0 = g.A1 = g.A2 = (const bf16_t*)(p->ws + WS_XN); g.B0 = g.B1 = g.B2 = (const bf16_t*)(p->ws + WS_WGU + l * SZ_WGU); g.lda = 2048; g.ldb = 2048; g.K = 2048;
            pg8::TileOrder S; S.init(MP, 11264, G, fresh_bid(), 1);
            EpiFfnUp E; E.O = (bf16_t*)(p->ws + WS_FF);
            for (int rep = 0; rep < REP_UP; ++rep) pg8::gemm_phase(lds, g, S, E);
        }
        GSYNC();
        {
            ParamsK p = fresh_params();
            const float* X1 = (const float*)(p->ws + WS_X1);
            pg8::Gemm g; g.A0 = g.A1 = g.A2 = (const bf16_t*)(p->ws + WS_FF); g.B0 = g.B1 = g.B2 = (const bf16_t*)(p->ws + WS_WDN + l * SZ_WDN); g.lda = DFF; g.ldb = DFF; g.K = DFF;
            pg8::TileOrder S; S.init(NPROMPT, DM, G, fresh_bid(), 1);
            EpiResid E; E.O = (float*)(p->ws + WS_X2); E.zero = (DBG_ZMASK >> 3) & 1; E.res.a = X1; E.res.b = X1; E.res.split = MP; E.res.valid = MP;
            for (int rep = 0; rep < REP_DN; ++rep) { pg8::gemm_phase(lds, g, S, E);
                skinny_resid((const bf16_t*)(p->ws + WS_FF), DFF, (const bf16_t*)(p->ws + WS_WDN + l * SZ_WDN), DFF, DFF, E.res, E.O, lds); }
        }
        GSYNC();
        { ParamsK p = fresh_params(); const float* X2 = (const float*)(p->ws + WS_X2); XSrc s; s.a = X2; s.b = X2; s.split = MP; s.valid = MP;
          if (l == 0) norm_rows(s, p->in[6] + DM, (bf16_t*)(p->ws + WS_XN), nullptr); else norm_rows(s, p->in[29], nullptr, p->out + O_Y); }
        if (l == 0) GSYNC();
    }
}

extern "C" void kernel_launch(void* const* d_in, const int* in_sizes, int n_in, void* d_out, int out_size, void* d_ws, size_t ws_size, hipStream_t stream) {
    static int grid_blocks = 0;
    if (grid_blocks == 0) {
        if (n_in != 30 || ws_size < WS_TOTAL) { fprintf(stderr, "kernel_launch: unexpected n_in %d / ws_size %zu (need %zu)\n", n_in, ws_size, (size_t)WS_TOTAL); grid_blocks = -1; return; }
        int dev = 0, cus = 0, per_cu = 0;
        (void)hipGetDevice(&dev);
        (void)hipDeviceGetAttribute(&cus, hipDeviceAttributeMultiprocessorCount, dev);
        if (hipFuncSetAttribute((const void*)hybrid_fwd, hipFuncAttributeMaxDynamicSharedMemorySize, LDS_BYTES) != hipSuccess) { fprintf(stderr, "kernel_launch: hipFuncSetAttribute failed\n"); grid_blocks = -1; return; }
        if (hipOccupancyMaxActiveBlocksPerMultiprocessor(&per_cu, (const void*)hybrid_fwd, 512, LDS_BYTES) != hipSuccess || per_cu < 1) { fprintf(stderr, "kernel_launch: occupancy query gave %d\n", per_cu); per_cu = 1; }
        (void)hipGetLastError();
        grid_blocks = cus * 1;
    }
    if (grid_blocks < 0) return;
    if (hipMemsetAsync((char*)d_ws + WS_BAR, 0, 16384, stream) != hipSuccess) { fprintf(stderr, "kernel_launch: memset of the barrier words failed\n"); return; }
    Params p{};
    for (int i = 0; i < 30; ++i) p.in[i] = (const float*)d_in[i];
    p.out = (float*)d_out; p.ws = (unsigned char*)d_ws;
    void* args[] = {&p};
    hipError_t e = hipLaunchCooperativeKernel((const void*)hybrid_fwd, dim3(grid_blocks), dim3(512), args, LDS_BYTES, stream);
    if (e != hipSuccess) fprintf(stderr, "cooperative launch failed: %s (grid %d)\n", hipGetErrorString(e), grid_blocks);
}
```

```cpp
#include <hip/hip_runtime.h>
#include <hip/hip_cooperative_groups.h>
#include <cstdio>
namespace cg = cooperative_groups;

#define LAS __attribute__((address_space(3)))
typedef unsigned short bf16_t;
typedef short bf16x8 __attribute__((ext_vector_type(8)));
typedef float f32x4 __attribute__((ext_vector_type(4)));
typedef float f32x2 __attribute__((ext_vector_type(2)));
typedef unsigned u32x4 __attribute__((ext_vector_type(4)));
typedef unsigned u32x2 __attribute__((ext_vector_type(2)));

constexpr int DM = 2048, NPROMPT = 8192, NSAMP = 128, MROWS = 8320, MP = 8448, SEQ = 2048, NB = 4;
constexpr int NIN = 14592, DFF = 5632, WIN_SRC = 14352;
constexpr int OFF_U = 0, OFF_GQ = 1024, OFF_GK = 1536, OFF_GV = 2048, OFF_GR = 3072, OFF_RQ = 4096, OFF_RK = 5120, OFF_RV = 6144, OFF_RG = 7168, OFF_MG = 8192, OFF_GLR = 14336;
constexpr int LDS_BYTES = 131072 + 16;
#ifndef REP_PRE
#define REP_PRE 1
#endif
#ifndef REP_MIX
#define REP_MIX 1
#endif
#ifndef REP_INPROJ
#define REP_INPROJ 1
#endif
#ifndef REP_SYNC
#define REP_SYNC 0
#endif
#ifndef REP_S5
#define REP_S5 1
#endif
#ifndef REP_RS
#define REP_RS 1
#endif
#ifndef REP_UP
#define REP_UP 1
#endif
#ifndef REP_DN
#define REP_DN 1
#endif
#ifndef REP_MG
#define REP_MG 1
#endif
#ifndef REP_MO
#define REP_MO 1
#endif
#ifndef REP_POST
#define REP_POST 1
#endif
#ifndef REP_NORM
#define REP_NORM 1
#endif
#ifndef DBG_ZMASK
#define DBG_ZMASK 0
#endif

constexpr size_t SZ_WIN = (size_t)NIN * 2048 * 2, SZ_WGLU = (size_t)1024 * 1024 * 2, SZ_WBR = (size_t)2048 * 1024 * 2, SZ_WMIX = (size_t)2048 * 2048 * 2,
                 SZ_WGU = (size_t)11264 * 2048 * 2, SZ_WDN = (size_t)2048 * 5632 * 2;
constexpr size_t WS_WIN = 0;
constexpr size_t WS_WGLU = WS_WIN + 2 * SZ_WIN;
constexpr size_t WS_WS5O = WS_WGLU + 2 * SZ_WGLU;
constexpr size_t WS_WGLAO = WS_WS5O + 2 * SZ_WBR;
constexpr size_t WS_WRETO = WS_WGLAO + 2 * SZ_WBR;
constexpr size_t WS_WMIX = WS_WRETO + 2 * SZ_WBR;
constexpr size_t WS_WGU = WS_WMIX + 2 * SZ_WMIX;
constexpr size_t WS_WDN = WS_WGU + 2 * SZ_WGU;
constexpr size_t WS_XN = WS_WDN + 2 * SZ_WDN;
constexpr size_t WS_PROJ = WS_XN + (size_t)MP * 2048 * 2;
constexpr size_t WS_Y5G = WS_PROJ + (size_t)MP * NIN * 2;
constexpr size_t WS_ORAW = WS_Y5G + (size_t)MP * 1024 * 2;
constexpr size_t WS_AS5 = WS_ORAW + (size_t)MP * 2048 * 4;
constexpr size_t WS_AGLA = WS_AS5 + (size_t)MP * 1024 * 2;
constexpr size_t WS_ARET = WS_AGLA + (size_t)MP * 1024 * 2;
constexpr size_t WS_MERGED = WS_ARET + (size_t)MP * 1024 * 2;
constexpr size_t WS_X1 = WS_MERGED + (size_t)MP * 2048 * 2;
constexpr size_t WS_X2 = WS_X1 + (size_t)MP * 2048 * 4;
constexpr size_t WS_ROT = WS_X2 + (size_t)MP * 2048 * 4;
constexpr size_t WS_S5A = WS_ROT + (size_t)2049 * 64 * 8 + 512;
constexpr size_t WS_S5B = WS_S5A + (size_t)2 * 64 * 64 * 16;
constexpr size_t WS_S5C = WS_S5B + (size_t)2 * 64 * 64 * 16 * 8;
constexpr size_t WS_S5BM = WS_S5C + (size_t)2 * 64 * 16 * 128 * 2;
constexpr size_t WS_END = WS_S5BM + (size_t)2 * 64 * 2 * 128 * 16 * 2;
constexpr size_t WS_FF = WS_PROJ;
constexpr size_t WS_BAR = WS_END;
constexpr size_t WS_BCUM = WS_BAR + 16384;
constexpr size_t WS_TOTAL = WS_BCUM + (size_t)NPROMPT * 512 * 4;
static_assert(WS_TOTAL <= (size_t)940572672, "workspace budget");
static_assert((size_t)MP * DFF * 2 <= (size_t)MP * NIN * 2, "ff alias");

constexpr size_t O_Y = 0, O_PS5R = 17039360, O_PS5I = 17072128, O_PGLA = 17104896, O_PRET = 18153472, O_SS5R = 19202048, O_SS5I = 20250624, O_SGLA = 21299200, O_SRET = 54853632;

struct Params { const float* in[30]; float* out; unsigned char* ws; };
typedef const __attribute__((address_space(4))) Params* ParamsK;
__device__ __forceinline__ ParamsK fresh_params() { unsigned long long a = (unsigned long long)__builtin_amdgcn_kernarg_segment_ptr(); asm volatile("" : "+s"(a)); return (ParamsK)a; }
__device__ __forceinline__ int fresh_tid() { int t = threadIdx.x; asm volatile("" : "+v"(t)); return t; }
__device__ __forceinline__ int fresh_bid() { int t = blockIdx.x; asm volatile("" : "+s"(t)); return t; }

typedef __bf16 bf16x2_t __attribute__((ext_vector_type(2)));
__device__ __forceinline__ unsigned cvt_pk_bf16(float lo, float hi) { const f32x2 v = {lo, hi}; const bf16x2_t b = __builtin_convertvector(v, bf16x2_t); return __builtin_bit_cast(unsigned, b); }
__device__ __forceinline__ bf16_t f2bf(float f) { return (bf16_t)(cvt_pk_bf16(f, 0.f) & 0xffffu); }
__device__ __forceinline__ float bf2f(bf16_t b) { return __uint_as_float(((unsigned)b) << 16); }
__device__ __forceinline__ float bflo(unsigned u) { return __uint_as_float(u << 16); }
__device__ __forceinline__ float bfhi(unsigned u) { return __uint_as_float(u & 0xffff0000u); }
__device__ __forceinline__ float sigmoidf_(float x) { return __builtin_amdgcn_rcpf(1.0f + __expf(-x)); }
__device__ __forceinline__ float siluf_(float x) { return x * sigmoidf_(x); }
__device__ __forceinline__ float geluf_(float x) { return x * sigmoidf_(1.5957691216057308f * (x + 0.044715f * x * x * x)); }
__device__ __forceinline__ float logsigmoidf_(float x) { return fminf(x, 0.f) - __logf(1.0f + __expf(-fabsf(x))); }

struct XSrc { const float* a; const float* b; int split, valid;
    __device__ __forceinline__ const float* row(int r) const { return r < split ? a + (size_t)r * DM : b + (size_t)(r - split) * DM; } };

namespace pg8 {
constexpr int BM = 256, BK = 64, HALF = 128, HTB = HALF * BK * 2, STAGE_BYTES = 8 * HTB, NXCD = 8, WGM = 8;
__device__ __forceinline__ int lds_byte(int r, int c) { const int st = (r >> 4) * 2 + (c >> 5), rr = r & 15, cc = c & 31, ob = rr * 64 + cc * 2; return st * 1024 + (ob ^ (((ob >> 9) & 1) << 5)); }
__device__ __forceinline__ void stage_rc(int b, int& R, int& C) { const int st = b / 1024, sb = b % 1024, swz = sb ^ (((sb >> 9) & 1) << 5); R = (st >> 1) * 16 + swz / 64; C = (st & 1) * 32 + (swz % 64) / 2; }
__device__ __forceinline__ int perm32(int rho) { const int n = rho >> 4, i = rho & 15; return 8 * (i >> 2) + 4 * n + (i & 3); }

struct Unit { int pm, pn, z; };
struct Gemm { const bf16_t* A0; const bf16_t* A1; const bf16_t* A2; const bf16_t* B0; const bf16_t* B1; const bf16_t* B2; int lda, ldb, K; };
struct TileOrder {
    int nM, nN, nwg, G, c, nz, cut, shift;
    __device__ void init(int M, int N, int G_, int c_, int nz_) { nM = M / BM; nN = N / BM; nwg = nM * nN; G = G_; c = c_; nz = nz_; cut = 1 << 30; shift = 0; }
    __device__ bool next(int i, Unit& u) const {
        const int it = i / nz; u.z = i - it * nz;
        const long L = (long)it * G + c; if (c < 0 || L >= nwg) return false;
        int wgid = (int)L; { const int q = nwg / NXCD, r = nwg % NXCD, xcd = wgid % NXCD, off = wgid / NXCD; wgid = (xcd < r ? xcd * (q + 1) : r * (q + 1) + (xcd - r) * q) + off; }
        const int nig = WGM * nN, gid = wgid / nig, fm = gid * WGM, gsz = (nM - fm) < WGM ? (nM - fm) : WGM;
        u.pm = fm + ((wgid % nig) % gsz); u.pn = (wgid % nig) / gsz; if (u.pn >= cut) u.pn += shift; return true;
    }
};

template <class Epi>
__device__ __forceinline__ void gemm_phase(LAS unsigned char* lds, const Gemm g, const TileOrder& S, const Epi& E) {
    const int tid = fresh_tid(), wid = __builtin_amdgcn_readfirstlane(tid >> 6), lane = tid & 63, wr = wid >> 2, wc = wid & 3, fr = lane & 15, fq = lane >> 4;
    const int K = g.K, nt = K / BK;
    unsigned voffA[2], voffB[2];
#pragma unroll
    for (int i = 0; i < 2; ++i) { int R, C; stage_rc(tid * 16 + i * 8192, R, C); const int Rb = Epi::PERM ? ((R & ~31) + perm32(R & 31)) : R;
        voffA[i] = (unsigned)(R * g.lda + C) * 2u; voffB[i] = (unsigned)(Rb * g.ldb + C) * 2u; }
    const size_t kstep = (size_t)(BK * 2);
    const size_t hstepA = (size_t)HALF * g.lda * 2, hstepB = (size_t)HALF * g.ldb * 2;
    const size_t tstepA = 2 * hstepA, tstepB = 2 * hstepB;
    const unsigned ldsw = (unsigned)wid * 1024u;
    const int aoff = lds_byte(wr * 64 + fr, fq * 8), boff = lds_byte(wc * 32 + fr, fq * 8);
#define PG8_SA(b, h) (((b) * 2 + (h)) * HTB)
#define PG8_SB(b, h) ((4 + (b) * 2 + (h)) * HTB)
#define PG8_STAGE(bufoff, gbase, voff) do { _Pragma("unroll") for (int _i = 0; _i < 2; ++_i) \
        __builtin_amdgcn_global_load_lds((const unsigned*)((const char*)(gbase) + (voff)[_i]), (LAS unsigned*)(lds + (bufoff) + ldsw + _i * 8192), 16, 0, 0); } while (0)
#define PG8_LDA(dst, b, h) do { _Pragma("unroll") for (int m = 0; m < 4; ++m) _Pragma("unroll") for (int k = 0; k < 2; ++k) dst[m][k] = *(const LAS bf16x8*)(lds + PG8_SA(b, h) + aoff + m * 2048 + k * 1024); } while (0)
#define PG8_LDB(dst, b, h) do { _Pragma("unroll") for (int n = 0; n < 2; ++n) _Pragma("unroll") for (int k = 0; k < 2; ++k) dst[n][k] = *(const LAS bf16x8*)(lds + PG8_SB(b, h) + boff + n * 2048 + k * 1024); } while (0)
#define PG8_MMA(ai, bj, At, Bt) do { __builtin_amdgcn_s_setprio(1); _Pragma("unroll") for (int m = 0; m < 4; ++m) _Pragma("unroll") for (int n = 0; n < 2; ++n) _Pragma("unroll") for (int k = 0; k < 2; ++k) \
        acc[ai][bj][m][n] = __builtin_amdgcn_mfma_f32_16x16x32_bf16(Bt[n][k], At[m][k], acc[ai][bj][m][n], 0, 0, 0); __builtin_amdgcn_s_setprio(0); } while (0)
#define PG8_WAIT_V(n) asm volatile("s_waitcnt vmcnt(" #n ")" ::: "memory")
#define PG8_WAIT_L(n) asm volatile("s_waitcnt lgkmcnt(" #n ")" ::: "memory")
#define PG8_BAR __builtin_amdgcn_s_barrier()
#define PG8_SCHED __builtin_amdgcn_sched_barrier(0)
#define PG8_BASEA(z) ((const char*)((z) == 0 ? g.A0 : ((z) == 1 ? g.A1 : g.A2)))
#define PG8_BASEB(z) ((const char*)((z) == 0 ? g.B0 : ((z) == 1 ? g.B1 : g.B2)))
    Unit cur, nxt; int ui = 0;
    if (!S.next(0, cur)) return;
    f32x4 acc[2][2][4][2];
#pragma unroll
    for (int a = 0; a < 2; ++a)
#pragma unroll
        for (int b = 0; b < 2; ++b)
#pragma unroll
            for (int m = 0; m < 4; ++m)
#pragma unroll
                for (int n = 0; n < 2; ++n) acc[a][b][m][n] = (f32x4){0.f, 0.f, 0.f, 0.f};
    bf16x8 At[4][2], B0[2][2], B1[2][2];
    const char* cA = PG8_BASEA(cur.z) + (size_t)cur.pm * tstepA; const char* cB = PG8_BASEB(cur.z) + (size_t)cur.pn * tstepB;
    PG8_STAGE(PG8_SB(0, 0), cB, voffB); PG8_STAGE(PG8_SA(0, 0), cA, voffA); PG8_STAGE(PG8_SB(0, 1), cB + hstepB, voffB); PG8_STAGE(PG8_SA(0, 1), cA + hstepA, voffA);
    if (wr == 1) PG8_BAR;
    PG8_WAIT_V(4); PG8_BAR;
    PG8_STAGE(PG8_SB(1, 0), cB + kstep, voffB); PG8_STAGE(PG8_SA(1, 0), cA + kstep, voffA); PG8_STAGE(PG8_SB(1, 1), cB + hstepB + kstep, voffB);
    PG8_WAIT_V(6); PG8_BAR;
    for (;;) {
        const bool has_next = S.next(ui + 1, nxt);
        const char* nA = has_next ? PG8_BASEA(nxt.z) + (size_t)nxt.pm * tstepA : cA; const char* nB = has_next ? PG8_BASEB(nxt.z) + (size_t)nxt.pn * tstepB : cB;
        for (int t = 0; t < nt; t += 2) {
            const bool last = (t == nt - 2);
            const char* a1 = cA + (size_t)(t + 1) * kstep;
            const char* a2 = last ? nA : cA + (size_t)(t + 2) * kstep; const char* b2 = last ? nB : cB + (size_t)(t + 2) * kstep;
            const char* a3 = a2 + kstep; const char* b3 = b2 + kstep;
            PG8_LDB(B0, 0, 0); PG8_SCHED; PG8_LDA(At, 0, 0); PG8_STAGE(PG8_SA(1, 1), a1 + hstepA, voffA);
            PG8_WAIT_L(8); PG8_BAR; PG8_WAIT_L(0); PG8_MMA(0, 0, At, B0); PG8_BAR; PG8_SCHED;
            PG8_LDB(B1, 0, 1); PG8_STAGE(PG8_SB(0, 0), b2, voffB);
            PG8_BAR; PG8_WAIT_L(0); PG8_MMA(0, 1, At, B1); PG8_BAR;
            PG8_LDA(At, 0, 1); PG8_STAGE(PG8_SA(0, 0), a2, voffA);
            PG8_BAR; PG8_WAIT_L(0); PG8_MMA(1, 0, At, B0); PG8_BAR; PG8_SCHED;
            PG8_STAGE(PG8_SB(0, 1), b2 + hstepB, voffB);
            PG8_WAIT_V(6); PG8_BAR; PG8_MMA(1, 1, At, B1); PG8_BAR;
            PG8_LDB(B0, 1, 0); PG8_SCHED; PG8_LDA(At, 1, 0); PG8_STAGE(PG8_SA(0, 1), a2 + hstepA, voffA);
            PG8_WAIT_L(8); PG8_BAR; PG8_WAIT_L(0); PG8_MMA(0, 0, At, B0); PG8_BAR; PG8_SCHED;
            PG8_LDB(B1, 1, 1); PG8_STAGE(PG8_SB(1, 0), b3, voffB);
            PG8_BAR; PG8_WAIT_L(0); PG8_MMA(0, 1, At, B1); PG8_BAR;
            PG8_LDA(At, 1, 1); PG8_STAGE(PG8_SA(1, 0), a3, voffA);
            PG8_BAR; PG8_WAIT_L(0); PG8_MMA(1, 0, At, B0); PG8_BAR; PG8_SCHED;
            PG8_STAGE(PG8_SB(1, 1), b3 + hstepB, voffB);
            PG8_WAIT_V(6); PG8_BAR; PG8_MMA(1, 1, At, B1); PG8_BAR;
        }
        E(acc, cur, wr, wc, fr, fq);
        if (!has_next) break;
        if (nxt.z == 0) {
#pragma unroll
            for (int a = 0; a < 2; ++a)
#pragma unroll
                for (int b = 0; b < 2; ++b)
#pragma unroll
                    for (int m = 0; m < 4; ++m)
#pragma unroll
                        for (int n = 0; n < 2; ++n) acc[a][b][m][n] = (f32x4){0.f, 0.f, 0.f, 0.f};
        }
        cur = nxt; cA = nA; cB = nB; ++ui;
    }
    PG8_WAIT_V(0);
    if (wr == 0) PG8_BAR;
    PG8_BAR;
#undef PG8_SA
#undef PG8_SB
#undef PG8_STAGE
#undef PG8_LDA
#undef PG8_LDB
#undef PG8_MMA
#undef PG8_WAIT_V
#undef PG8_WAIT_L
#undef PG8_BAR
#undef PG8_SCHED
#undef PG8_BASEA
#undef PG8_BASEB
}
}
using pg8::Unit;
typedef f32x4 AccT[2][2][4][2];

struct EpiInProj {
    static constexpr bool PERM = true;
    bf16_t* O; const float* rot;
    __device__ __forceinline__ void operator()(const AccT& acc, const Unit& u, int wr, int wc, int fr, int fq) const {
        const int pn = u.pn;
        int mode;
        if (pn < 4) mode = 0; else if (pn < 6) mode = 1; else if (pn < 12) mode = 0; else if (pn < 16) mode = 2; else if (pn < 20) mode = 4; else if (pn < 24) mode = 5;
        else if (pn < 28) mode = 0; else if (pn < 32) mode = 2; else if (pn < 56) mode = 3; else mode = 0;
        const float SC = 0.08838834764831845f;
#pragma unroll
        for (int ai = 0; ai < 2; ++ai)
#pragma unroll
            for (int m = 0; m < 4; ++m) {
                const int row = u.pm * 256 + ai * 128 + wr * 64 + m * 16 + fr;
                bf16_t* rowp = O + (size_t)row * NIN + pn * 256 + wc * 32 + 8 * fq;
                f32x4 r0 = (f32x4){1.f, 0.f, 1.f, 0.f}, r1 = r0;
                if (mode >= 4) { const int pidx = row < NPROMPT ? (row & (SEQ - 1)) : SEQ; const f32x4* rp = (const f32x4*)(rot + ((size_t)pidx * 64 + 16 * wc + 4 * fq) * 2); r0 = rp[0]; r1 = rp[1]; }
#pragma unroll
                for (int bj = 0; bj < 2; ++bj) {
                    f32x4 v0 = acc[ai][bj][m][0], v1 = acc[ai][bj][m][1];
                    if (mode >= 4) {
                        f32x4 a, b;
                        a[0] = v0[0] * r0[0] - v0[1] * r0[1]; a[1] = v0[1] * r0[0] + v0[0] * r0[1];
                        a[2] = v0[2] * r0[2] - v0[3] * r0[3]; a[3] = v0[3] * r0[2] + v0[2] * r0[3];
                        b[0] = v1[0] * r1[0] - v1[1] * r1[1]; b[1] = v1[1] * r1[0] + v1[0] * r1[1];
                        b[2] = v1[2] * r1[2] - v1[3] * r1[3]; b[3] = v1[3] * r1[2] + v1[2] * r1[3];
                        v0 = a; v1 = b;
                        if (mode == 5) { v0 *= SC; v1 *= SC; }
                    } else if (mode == 1) { v0 *= SC; v1 *= SC; }
                    else if (mode == 2) {
#pragma unroll
                        for (int j = 0; j < 4; ++j) { v0[j] = siluf_(v0[j]); v1[j] = siluf_(v1[j]); } }
                    else if (mode == 3) {
#pragma unroll
                        for (int j = 0; j < 4; ++j) { v0[j] = sigmoidf_(v0[j]); v1[j] = sigmoidf_(v1[j]); } }
                    u32x4 w; w.x = cvt_pk_bf16(v0[0], v0[1]); w.y = cvt_pk_bf16(v0[2], v0[3]); w.z = cvt_pk_bf16(v1[0], v1[1]); w.w = cvt_pk_bf16(v1[2], v1[3]);
                    *(u32x4*)(rowp + bj * 128) = w;
                }
            }
    }
};
struct EpiGlu {
    static constexpr bool PERM = true;
    bf16_t* O; const bf16_t* Y; const float* bias;
    __device__ __forceinline__ void operator()(const AccT& acc, const Unit& u, int wr, int wc, int fr, int fq) const {
#pragma unroll
        for (int bj = 0; bj < 2; ++bj) {
            const int col = u.pn * 256 + bj * 128 + wc * 32 + 8 * fq;
            const f32x4 b0 = *(const f32x4*)(bias + col), b1 = *(const f32x4*)(bias + col + 4);
#pragma unroll
            for (int ai = 0; ai < 2; ++ai)
#pragma unroll
                for (int m = 0; m < 4; ++m) {
                    const int row = u.pm * 256 + ai * 128 + wr * 64 + m * 16 + fr;
                    const u32x4 y = *(const u32x4*)(Y + (size_t)row * 1024 + col);
                    const f32x4 v0 = acc[ai][bj][m][0] + b0, v1 = acc[ai][bj][m][1] + b1;
                    u32x4 w;
                    w.x = cvt_pk_bf16(bflo(y.x) * sigmoidf_(v0[0]), bfhi(y.x) * sigmoidf_(v0[1]));
                    w.y = cvt_pk_bf16(bflo(y.y) * sigmoidf_(v0[2]), bfhi(y.y) * sigmoidf_(v0[3]));
                    w.z = cvt_pk_bf16(bflo(y.z) * sigmoidf_(v1[0]), bfhi(y.z) * sigmoidf_(v1[1]));
                    w.w = cvt_pk_bf16(bflo(y.w) * sigmoidf_(v1[2]), bfhi(y.w) * sigmoidf_(v1[3]));
                    *(u32x4*)(O + (size_t)row * 1024 + col) = w;
                }
        }
    }
};
struct EpiMerge {
    static constexpr bool PERM = false;
    bf16_t* O; const bf16_t* proj;
    __device__ __forceinline__ void operator()(AccT& acc, const Unit& u, int wr, int wc, int fr, int fq) const {
        const int z = u.z;
#pragma unroll
        for (int ai = 0; ai < 2; ++ai)
#pragma unroll
            for (int m = 0; m < 4; ++m) {
                const int row = u.pm * 256 + ai * 128 + wr * 64 + m * 16 + fr;
#pragma unroll
                for (int bj = 0; bj < 2; ++bj)
#pragma unroll
                    for (int n = 0; n < 2; ++n) {
                        const int col = u.pn * 256 + bj * 128 + wc * 32 + n * 16 + 4 * fq;
                        const bf16_t* gp = proj + (size_t)row * NIN + OFF_MG + z * 2048 + col;
                        const u32x2 ga = *(const u32x2*)gp;
                        f32x4 v = acc[ai][bj][m][n];
                        v[0] *= bflo(ga.x); v[1] *= bfhi(ga.x); v[2] *= bflo(ga.y); v[3] *= bfhi(ga.y);
                        if ((DBG_ZMASK >> z) & 1) v = (f32x4){0.f, 0.f, 0.f, 0.f};
                        if (z < 2) {
                            const u32x2 gb = *(const u32x2*)(gp + 2048);
                            v[0] *= __builtin_amdgcn_rcpf(fmaxf(bflo(gb.x), 1e-30f)); v[1] *= __builtin_amdgcn_rcpf(fmaxf(bfhi(gb.x), 1e-30f));
                            v[2] *= __builtin_amdgcn_rcpf(fmaxf(bflo(gb.y), 1e-30f)); v[3] *= __builtin_amdgcn_rcpf(fmaxf(bfhi(gb.y), 1e-30f));
                            acc[ai][bj][m][n] = v;
                        } else { u32x2 w; w.x = cvt_pk_bf16(v[0], v[1]); w.y = cvt_pk_bf16(v[2], v[3]); *(u32x2*)(O + (size_t)row * DM + col) = w; }
                    }
            }
    }
};
struct EpiResid {
    static constexpr bool PERM = false;
    float* O; XSrc res; int zero;
    __device__ __forceinline__ void operator()(const AccT& acc, const Unit& u, int wr, int wc, int fr, int fq) const {
#pragma unroll
        for (int ai = 0; ai < 2; ++ai)
#pragma unroll
            for (int m = 0; m < 4; ++m) {
                const int row = u.pm * 256 + ai * 128 + wr * 64 + m * 16 + fr;
                const bool ok = row < res.valid;
                const float* rp = res.row(ok ? row : 0);
#pragma unroll
                for (int bj = 0; bj < 2; ++bj)
#pragma unroll
                    for (int n = 0; n < 2; ++n) {
                        const int col = u.pn * 256 + bj * 128 + wc * 32 + n * 16 + 4 * fq;
                        f32x4 v = acc[ai][bj][m][n];
                        if (zero) v = (f32x4){0.f, 0.f, 0.f, 0.f};
                        if (ok) v += *(const f32x4*)(rp + col);
                        *(f32x4*)(O + (size_t)row * DM + col) = v;
                    }
            }
    }
};
struct EpiFfnUp {
    static constexpr bool PERM = true;
    bf16_t* O;
    __device__ __forceinline__ void operator()(const AccT& acc, const Unit& u, int wr, int wc, int fr, int fq) const {
#pragma unroll
        for (int ai = 0; ai < 2; ++ai)
#pragma unroll
            for (int m = 0; m < 4; ++m) {
                const int row = u.pm * 256 + ai * 128 + wr * 64 + m * 16 + fr;
                const f32x4 g0 = acc[ai][0][m][0], g1 = acc[ai][0][m][1], u0 = acc[ai][1][m][0], u1 = acc[ai][1][m][1];
                u32x4 w;
                w.x = cvt_pk_bf16(siluf_(g0[0]) * u0[0], siluf_(g0[1]) * u0[1]); w.y = cvt_pk_bf16(siluf_(g0[2]) * u0[2], siluf_(g0[3]) * u0[3]);
                w.z = cvt_pk_bf16(siluf_(g1[0]) * u1[0], siluf_(g1[1]) * u1[1]); w.w = cvt_pk_bf16(siluf_(g1[2]) * u1[2], siluf_(g1[3]) * u1[3]);
                *(u32x4*)(O + (size_t)row * DFF + u.pn * 128 + wc * 32 + 8 * fq) = w;
            }
    }
};

struct ConvTile { const float* src; bf16_t* dst; int ldw, ldt, valid; };
__device__ __forceinline__ ConvTile conv_decode(ParamsK p, int id) {
    const int PER_LAYER = 18560;
    ConvTile c; c.valid = 64;
    const int l = id / PER_LAYER; int t = id - l * PER_LAYER;
    if (t < 7296) { const int tk = t / 228, tn = t % 228, n0 = tn * 64; int sc;
        if (n0 < 4096) sc = n0; else if (n0 < 14336) sc = n0 + 16; else if (n0 == 14336) { sc = 4096; c.valid = 16; } else { sc = 0; c.valid = 0; }
        c.ldw = WIN_SRC; c.src = p->in[7] + (size_t)l * 2048 * WIN_SRC + (size_t)(tk * 64) * c.ldw + sc; c.ldt = 2048; c.dst = (bf16_t*)(p->ws + WS_WIN + l * SZ_WIN) + (size_t)n0 * c.ldt + tk * 64; }
    else if (t < 7552) { t -= 7296; const int tk = t / 16, tn = t % 16; c.ldw = 1024; c.src = p->in[16] + (size_t)l * 1024 * 1024 + (size_t)(tk * 64) * c.ldw + tn * 64; c.ldt = 1024; c.dst = (bf16_t*)(p->ws + WS_WGLU + l * SZ_WGLU) + (size_t)(tn * 64) * c.ldt + tk * 64; }
    else if (t < 9088) { t -= 7552; const int which = t / 512; t -= which * 512; const int tk = t / 32, tn = t % 32; c.ldw = 2048;
        const float* base = which == 0 ? p->in[18] : (which == 1 ? p->in[22] : p->in[23]);
        const size_t wo = which == 0 ? WS_WS5O : (which == 1 ? WS_WGLAO : WS_WRETO);
        c.src = base + (size_t)l * 1024 * 2048 + (size_t)(tk * 64) * c.ldw + tn * 64; c.ldt = 1024; c.dst = (bf16_t*)(p->ws + wo + l * SZ_WBR) + (size_t)(tn * 64) * c.ldt + tk * 64; }
    else if (t < 10112) { t -= 9088; const int tk = t / 32, tn = t % 32; c.ldw = 2048; c.src = p->in[24] + (size_t)l * 2048 * 2048 + (size_t)(tk * 64) * c.ldw + tn * 64; c.ldt = 2048; c.dst = (bf16_t*)(p->ws + WS_WMIX + l * SZ_WMIX) + (size_t)(tn * 64) * c.ldt + tk * 64; }
    else if (t < 15744) { t -= 10112; const int tk = t / 176, tn = t % 176, n0 = tn * 64, pn = n0 >> 8, within = n0 & 255; const bool isup = within >= 128; const int ff0 = pn * 128 + (within & 127);
        c.ldw = DFF; c.src = (isup ? p->in[27] : p->in[26]) + (size_t)l * 2048 * DFF + (size_t)(tk * 64) * c.ldw + ff0; c.ldt = 2048; c.dst = (bf16_t*)(p->ws + WS_WGU + l * SZ_WGU) + (size_t)n0 * c.ldt + tk * 64; }
    else { t -= 15744; const int tk = t / 32, tn = t % 32; c.ldw = 2048; c.src = p->in[28] + (size_t)l * DFF * 2048 + (size_t)(tk * 64) * c.ldw + tn * 64; c.ldt = DFF; c.dst = (bf16_t*)(p->ws + WS_WDN + l * SZ_WDN) + (size_t)(tn * 64) * c.ldt + tk * 64; }
    return c;
}
__device__ __forceinline__ void conv_weights(ParamsK p, LAS float* T) {
    const int tid = fresh_tid();
    const int kk = tid >> 4, n4 = (tid & 15) * 4;
    const int n = tid >> 3, k8 = (tid & 7) * 8;
    const int TOTAL = 2 * 18560;
    for (int id0 = fresh_bid() * 4; id0 < TOTAL; id0 += gridDim.x * 4) {
        f32x4 v[4][2]; bf16_t* dstp[4];
#pragma unroll
        for (int u = 0; u < 4; ++u) {
            const ConvTile c = conv_decode(p, id0 + u);
            dstp[u] = c.dst + (size_t)n * c.ldt + k8;
#pragma unroll
            for (int ps = 0; ps < 2; ++ps) { v[u][ps] = (f32x4){0.f, 0.f, 0.f, 0.f}; if (n4 < c.valid) v[u][ps] = __builtin_nontemporal_load((const f32x4*)(c.src + (size_t)(kk + 32 * ps) * c.ldw + n4)); }
        }
#pragma unroll
        for (int u = 0; u < 4; ++u)
#pragma unroll
            for (int ps = 0; ps < 2; ++ps) { LAS float* tp = T + u * 4160 + (kk + 32 * ps) * 65 + n4; tp[0] = v[u][ps][0]; tp[1] = v[u][ps][1]; tp[2] = v[u][ps][2]; tp[3] = v[u][ps][3]; }
        __syncthreads();
#pragma unroll
        for (int u = 0; u < 4; ++u) {
            const LAS float* tp = T + u * 4160 + k8 * 65 + n;
            u32x4 w;
            w.x = cvt_pk_bf16(tp[0 * 65], tp[1 * 65]); w.y = cvt_pk_bf16(tp[2 * 65], tp[3 * 65]); w.z = cvt_pk_bf16(tp[4 * 65], tp[5 * 65]); w.w = cvt_pk_bf16(tp[6 * 65], tp[7 * 65]);
            *(u32x4*)dstp[u] = w;
        }
        __syncthreads();
    }
}

__device__ __forceinline__ void sincos_d(double a, double& s, double& c) {
    const double qd = rint(a * 0.63661977236758134);
    double rr = fma(-qd, 1.5707963267948966, a); rr = fma(-qd, 6.123233995736766e-17, rr);
    const int qi = ((int)qd) & 3;
    const double x2 = rr * rr;
    const double sp = rr * (1.0 + x2 * (-1.0 / 6 + x2 * (1.0 / 120 + x2 * (-1.0 / 5040 + x2 * (1.0 / 362880 + x2 * (-1.0 / 39916800 + x2 * (1.0 / 6227020800.0 + x2 * (-1.0 / 1307674368000.0))))))));
    const double cp = 1.0 + x2 * (-0.5 + x2 * (1.0 / 24 + x2 * (-1.0 / 720 + x2 * (1.0 / 40320 + x2 * (-1.0 / 3628800 + x2 * (1.0 / 479001600.0 + x2 * (-1.0 / 87178291200.0 + x2 * (1.0 / 20922789888000.0))))))));
    if (qi == 0) { s = sp; c = cp; } else if (qi == 1) { s = cp; c = -sp; } else if (qi == 2) { s = -sp; c = -cp; } else { s = -cp; c = sp; }
}

__device__ __forceinline__ void norm_rows(const XSrc src, const float* gain, bf16_t* dbf, float* df32) {
    const int lane = fresh_tid() & 63, gw = fresh_bid() * 8 + (fresh_tid() >> 6), nw = gridDim.x * 8;
    for (int row = gw; row < MROWS; row += 2 * nw) {
        const int row2 = row + nw < MROWS ? row + nw : row;
        const float* xp = src.row(row); const float* xq = src.row(row2);
        f32x4 v[8], u[8]; float ss = 0.f, st = 0.f;
#pragma unroll
        for (int i = 0; i < 8; ++i) { v[i] = *(const f32x4*)(xp + i * 256 + lane * 4); u[i] = *(const f32x4*)(xq + i * 256 + lane * 4); }
#pragma unroll
        for (int i = 0; i < 8; ++i) { ss += v[i][0] * v[i][0] + v[i][1] * v[i][1] + v[i][2] * v[i][2] + v[i][3] * v[i][3]; st += u[i][0] * u[i][0] + u[i][1] * u[i][1] + u[i][2] * u[i][2] + u[i][3] * u[i][3]; }
#pragma unroll
        for (int o = 32; o > 0; o >>= 1) { ss += __shfl_xor(ss, o); st += __shfl_xor(st, o); }
        const float rs = 1.0f / sqrtf(ss * (1.0f / DM) + 1e-6f), rt = 1.0f / sqrtf(st * (1.0f / DM) + 1e-6f);
#pragma unroll
        for (int i = 0; i < 8; ++i) {
            const f32x4 gn = *(const f32x4*)(gain + i * 256 + lane * 4);
            const f32x4 y = v[i] * rs * gn, y2 = u[i] * rt * gn;
            if (dbf) { u32x2 w; w.x = cvt_pk_bf16(y[0], y[1]); w.y = cvt_pk_bf16(y[2], y[3]); *(u32x2*)(dbf + (size_t)row * DM + i * 256 + lane * 4) = w;
                       if (row2 != row) { w.x = cvt_pk_bf16(y2[0], y2[1]); w.y = cvt_pk_bf16(y2[2], y2[3]); *(u32x2*)(dbf + (size_t)row2 * DM + i * 256 + lane * 4) = w; } }
            if (df32) { *(f32x4*)(df32 + (size_t)row * DM + i * 256 + lane * 4) = y; if (row2 != row) *(f32x4*)(df32 + (size_t)row2 * DM + i * 256 + lane * 4) = y2; }
        }
    }
}

__device__ __forceinline__ void phase_prepass(ParamsK p, LAS unsigned char* lds) {
    conv_weights(p, (LAS float*)lds);
    const int gt = fresh_bid() * 512 + fresh_tid(), ngt = gridDim.x * 512;
    for (int i = gt; i < 2049 * 64; i += ngt) {
        const int pidx = i >> 6, fi = i & 63;
        const double inv = exp(-((double)fi / 63.0) * 9.210340371976184);
        const double pos = pidx < SEQ ? (double)pidx : 16384.0;
        double s, c; sincos_d(pos * inv, s, c);
        ((f32x2*)(p->ws + WS_ROT))[i] = (f32x2){(float)c, (float)s};
    }
    for (int i = gt; i < 2 * 64 * 64; i += ngt) {
        const int l = i >> 12, g = (i >> 6) & 63, pp = i & 63;
        const double dt = exp((double)p->in[10][l * 64 + g]);
        const double ar = p->in[8][i], ai = p->in[9][i];
        const double mag = exp(ar * dt); double s, c; sincos_d(ai * dt, s, c);
        const double abr = mag * c, abi = mag * s, den = ar * ar + ai * ai, nr = abr - 1.0, ni = abi;
        const double fr = (nr * ar + ni * ai) / den, fi = (ni * ar - nr * ai) / den;
        double zr = abr, zi = abi;
#pragma unroll 1
        for (int k = 0; k < 6; ++k) { const double t = zr * zr - zi * zi; zi = 2.0 * zr * zi; zr = t; }
        ((f32x4*)(p->ws + WS_S5A))[i] = (f32x4){(float)abr, (float)abi, (float)zr, (float)zi};
        const float* br = p->in[11] + (size_t)i * 16; const float* bi = p->in[12] + (size_t)i * 16;
        f32x2* bo = (f32x2*)(p->ws + WS_S5B) + (size_t)i * 16;
        bf16_t* bmt = (bf16_t*)(p->ws + WS_S5BM) + (size_t)(l * 64 + g) * 2 * 128 * 16;
#pragma unroll 1
        for (int n = 0; n < 16; ++n) { const double b_r = br[n], b_i = bi[n]; const float vr = (float)(fr * b_r - fi * b_i), vi = (float)(fr * b_i + fi * b_r);
            bo[n] = (f32x2){vr, vi}; const bf16_t hr = f2bf(vr), hi = f2bf(vi);
            bmt[pp * 16 + n] = hr; bmt[(64 + pp) * 16 + n] = hi; bmt[2048 + pp * 16 + n] = f2bf(vr - bf2f(hr)); bmt[2048 + (64 + pp) * 16 + n] = f2bf(vi - bf2f(hi)); }
        bf16_t* cm = (bf16_t*)(p->ws + WS_S5C) + (size_t)(l * 64 + g) * 16 * 128;
        const float* cr = p->in[13] + (size_t)(l * 64 + g) * 16 * 64; const float* ci = p->in[14] + (size_t)(l * 64 + g) * 16 * 64;
#pragma unroll 1
        for (int n = 0; n < 16; ++n) { cm[n * 128 + pp] = f2bf(cr[n * 64 + pp]); cm[n * 128 + 64 + pp] = f2bf(-ci[n * 64 + pp]); }
    }
    XSrc x0; x0.a = p->in[0]; x0.b = p->in[1]; x0.split = NPROMPT; x0.valid = MROWS;
    norm_rows(x0, p->in[6], (bf16_t*)(p->ws + WS_XN), nullptr);
}

__device__ __forceinline__ f32x4 mma_lds(f32x4 acc, const LAS bf16_t* A, int lda, const LAS bf16_t* B, int ldb, int K, int lane) {
    const int r = lane & 15, q = lane >> 4;
    const LAS bf16_t* ap = A + r * lda + q * 8; const LAS bf16_t* bp = B + r * ldb + q * 8;
    for (int k = 0; k < K; k += 32) {
        const bf16x8 a = *(const LAS bf16x8*)(ap + k), b = *(const LAS bf16x8*)(bp + k);
        acc = __builtin_amdgcn_mfma_f32_16x16x32_bf16(a, b, acc, 0, 0, 0);
    }
    return acc;
}


__device__ __forceinline__ void phase_gates(ParamsK p, int l) {
    const bf16_t* proj = (const bf16_t*)(p->ws + WS_PROJ);
    float* bcum = (float*)(p->ws + WS_BCUM);
    for (int idx = fresh_bid() * 512 + fresh_tid(); idx < 128 * 512; idx += gridDim.x * 512) {
        const int c = idx >> 9, hk = idx & 511;
        float wg[16];
#pragma unroll
        for (int rr = 0; rr < 16; ++rr) wg[rr] = p->in[19][((size_t)l * 16 + rr) * 512 + hk];
        const float bias = p->in[20][l * 512 + hk];
        float cum = 0.f;
#pragma unroll 16
        for (int t = 0; t < 64; ++t) {
            const size_t row = (size_t)c * 64 + t;
            const u32x4 g0 = *(const u32x4*)(proj + row * NIN + OFF_GLR), g1 = *(const u32x4*)(proj + row * NIN + OFF_GLR + 8);
            float lo = bias;
            lo += bflo(g0.x) * wg[0] + bfhi(g0.x) * wg[1] + bflo(g0.y) * wg[2] + bfhi(g0.y) * wg[3] + bflo(g0.z) * wg[4] + bfhi(g0.z) * wg[5] + bflo(g0.w) * wg[6] + bfhi(g0.w) * wg[7];
            lo += bflo(g1.x) * wg[8] + bfhi(g1.x) * wg[9] + bflo(g1.y) * wg[10] + bfhi(g1.y) * wg[11] + bflo(g1.z) * wg[12] + bfhi(g1.z) * wg[13] + bflo(g1.w) * wg[14] + bfhi(g1.w) * wg[15];
            cum += logsigmoidf_(lo) * 0.0625f;
            bcum[row * 512 + hk] = cum;
        }
    }
}

template <bool RET>
__device__ __forceinline__ void recur_item(ParamsK p, int l, int b, int h, int vs, LAS unsigned char* lds) {
    constexpr int DV = RET ? 128 : 256, NH = RET ? 8 : 4;
    const int tid = fresh_tid(), w = tid >> 6, lane = tid & 63, r = lane & 15, q = lane >> 4;
    LAS float* Bc = (LAS float*)lds;
    LAS bf16_t* Qt = (LAS bf16_t*)(lds + 32768);
    LAS bf16_t* Kt = Qt + 64 * 136;
    LAS bf16_t* KhT = Kt + 64 * 136;
    LAS bf16_t* Vt = KhT + 128 * 72;
    LAS bf16_t* Pm = Vt + 64 * 72;
    LAS bf16_t* St = Pm + 64 * 72;
    LAS float* Gl = (LAS float*)(St + 64 * 136);
    LAS float* Gs = Gl + 64 * 16;
    const bf16_t* proj = (const bf16_t*)(p->ws + WS_PROJ);
    float* oraw = (float*)(p->ws + WS_ORAW);
    const int qcol = (RET ? OFF_RQ : OFF_GQ) + h * 128, kcol = (RET ? OFF_RK : OFF_GK) + h * 128, vcol = (RET ? OFF_RV : OFF_GV) + h * DV + vs * 64;
    const int ocol = (RET ? 1024 + h * 128 : h * 256) + vs * 64;
    for (int i = tid; i < 64 * 136; i += 512) St[i] = 0;
    const float* bcum = (const float*)(p->ws + WS_BCUM) + h * 128;
    const float lg = log1pf(-exp2f(-5.0f - (float)h));
    (void)Bc;
    f32x4 accS[4];
#pragma unroll
    for (int i = 0; i < 4; ++i) accS[i] = (f32x4){0.f, 0.f, 0.f, 0.f};
    u32x4 nq[2], nk[2], nv; f32x4 nb[2][2], nl[2], nd;
    {
        const size_t row0 = (size_t)b * SEQ;
#pragma unroll
        for (int i = 0; i < 2; ++i) { const int idx = tid + i * 512, t = idx >> 4, kv = (idx & 15) * 8;
            nq[i] = *(const u32x4*)(proj + (row0 + t) * NIN + qcol + kv); nk[i] = *(const u32x4*)(proj + (row0 + t) * NIN + kcol + kv); }
        nv = *(const u32x4*)(proj + (row0 + (tid >> 3)) * NIN + vcol + (tid & 7) * 8);
        if (!RET) {
#pragma unroll
            for (int i = 0; i < 2; ++i) { const int idx = tid + i * 512, t = idx >> 4, kv = (idx & 15) * 8; nb[i][0] = *(const f32x4*)(bcum + (row0 + t) * 512 + kv); nb[i][1] = *(const f32x4*)(bcum + (row0 + t) * 512 + kv + 4); }
            { const int kv = (tid & 15) * 8; nl[0] = *(const f32x4*)(bcum + (row0 + 63) * 512 + kv); nl[1] = *(const f32x4*)(bcum + (row0 + 63) * 512 + kv + 4); nd = *(const f32x4*)(bcum + (row0 + 63) * 512 + 16 * w + q * 4); } }
    }
    __syncthreads();
    for (int c = 0; c < 32; ++c) {
        const size_t row0 = (size_t)b * SEQ + c * 64;
#pragma unroll
        for (int i = 0; i < 2; ++i) {
            const int idx = tid + i * 512, t = idx >> 4, kv = (idx & 15) * 8;
            float bb[8], bl[8];
            if (RET) {
#pragma unroll
                for (int j = 0; j < 8; ++j) { bb[j] = (float)(t + 1) * lg; bl[j] = 64.0f * lg; }
            } else {
                const f32x4 b0 = nb[i][0], b1 = nb[i][1], l0 = nl[0], l1 = nl[1];
                bb[0] = b0[0]; bb[1] = b0[1]; bb[2] = b0[2]; bb[3] = b0[3]; bb[4] = b1[0]; bb[5] = b1[1]; bb[6] = b1[2]; bb[7] = b1[3];
                bl[0] = l0[0]; bl[1] = l0[1]; bl[2] = l0[2]; bl[3] = l0[3]; bl[4] = l1[0]; bl[5] = l1[1]; bl[6] = l1[2]; bl[7] = l1[3];
            }
            float qf[8] = {bflo(nq[i].x), bfhi(nq[i].x), bflo(nq[i].y), bfhi(nq[i].y), bflo(nq[i].z), bfhi(nq[i].z), bflo(nq[i].w), bfhi(nq[i].w)};
            float kf[8] = {bflo(nk[i].x), bfhi(nk[i].x), bflo(nk[i].y), bfhi(nk[i].y), bflo(nk[i].z), bfhi(nk[i].z), bflo(nk[i].w), bfhi(nk[i].w)};
            float qt[8], kt[8];
#pragma unroll
            for (int j = 0; j < 8; ++j) { const float em = __expf(-bb[j]); qt[j] = qf[j] * __expf(bb[j]); kt[j] = kf[j] * em; KhT[(kv + j) * 72 + (t ^ (((kv >> 3) & 7) << 3))] = f2bf(kt[j] * __expf(bl[j])); }
            u32x4 wq, wk;
            wq.x = cvt_pk_bf16(qt[0], qt[1]); wq.y = cvt_pk_bf16(qt[2], qt[3]); wq.z = cvt_pk_bf16(qt[4], qt[5]); wq.w = cvt_pk_bf16(qt[6], qt[7]);
            wk.x = cvt_pk_bf16(kt[0], kt[1]); wk.y = cvt_pk_bf16(kt[2], kt[3]); wk.z = cvt_pk_bf16(kt[4], kt[5]); wk.w = cvt_pk_bf16(kt[6], kt[7]);
            *(LAS u32x4*)(Qt + t * 136 + kv) = wq; *(LAS u32x4*)(Kt + t * 136 + kv) = wk;
        }
        { const int t = tid >> 3, vv = (tid & 7) * 8; LAS bf16_t* vp = Vt + vv * 72 + (t ^ (((vv >> 3) & 7) << 3));
            vp[0 * 72] = (bf16_t)(nv.x & 0xffffu); vp[1 * 72] = (bf16_t)(nv.x >> 16); vp[2 * 72] = (bf16_t)(nv.y & 0xffffu); vp[3 * 72] = (bf16_t)(nv.y >> 16);
            vp[4 * 72] = (bf16_t)(nv.z & 0xffffu); vp[5 * 72] = (bf16_t)(nv.z >> 16); vp[6 * 72] = (bf16_t)(nv.w & 0xffffu); vp[7 * 72] = (bf16_t)(nv.w >> 16); }
        const f32x4 dec = RET ? (f32x4){__expf(64.0f * lg), __expf(64.0f * lg), __expf(64.0f * lg), __expf(64.0f * lg)} : (f32x4){__expf(nd[0]), __expf(nd[1]), __expf(nd[2]), __expf(nd[3])};
        if (c + 1 < 32) {
            const size_t rn = row0 + 64;
#pragma unroll
            for (int i = 0; i < 2; ++i) { const int idx = tid + i * 512, t = idx >> 4, kv = (idx & 15) * 8;
                nq[i] = *(const u32x4*)(proj + (rn + t) * NIN + qcol + kv); nk[i] = *(const u32x4*)(proj + (rn + t) * NIN + kcol + kv); }
            nv = *(const u32x4*)(proj + (rn + (tid >> 3)) * NIN + vcol + (tid & 7) * 8);
            if (!RET) {
#pragma unroll
                for (int i = 0; i < 2; ++i) { const int idx = tid + i * 512, t = idx >> 4, kv = (idx & 15) * 8; nb[i][0] = *(const f32x4*)(bcum + (rn + t) * 512 + kv); nb[i][1] = *(const f32x4*)(bcum + (rn + t) * 512 + kv + 4); }
                { const int kv = (tid & 15) * 8; nl[0] = *(const f32x4*)(bcum + (rn + 63) * 512 + kv); nl[1] = *(const f32x4*)(bcum + (rn + 63) * 512 + kv + 4); nd = *(const f32x4*)(bcum + (rn + 63) * 512 + 16 * w + q * 4); } }
        }
        __syncthreads();
        const int tm = w >> 1, vb = w & 1;
#pragma unroll
        for (int s2 = 0; s2 < 2; ++s2) {
            const int sn = (w & 1) * 2 + s2;
            f32x4 sc = mma_lds((f32x4){0.f, 0.f, 0.f, 0.f}, Qt + tm * 16 * 136, 136, Kt + sn * 16 * 136, 136, 128, lane);
#pragma unroll
            for (int j = 0; j < 4; ++j) if (sn > tm || (sn == tm && r > q * 4 + j)) sc[j] = 0.f;
#pragma unroll
            for (int j = 0; j < 4; ++j) Pm[(tm * 16 + q * 4 + j) * 72 + sn * 16 + r] = f2bf(sc[j]);
        }
        f32x4 acco[2];
#pragma unroll
        for (int u = 0; u < 2; ++u) acco[u] = mma_lds((f32x4){0.f, 0.f, 0.f, 0.f}, Qt + tm * 16 * 136, 136, St + (vb + 2 * u) * 16 * 136, 136, 128, lane);
        __syncthreads();
#pragma unroll
        for (int u = 0; u < 2; ++u) {
            { const int vt = vb + 2 * u, swv = ((2 * vt + (r >> 3)) & 7) << 3; const LAS bf16_t* pp = Pm + (tm * 16 + r) * 72 + q * 8; const LAS bf16_t* vr = Vt + (vt * 16 + r) * 72;
              acco[u] = __builtin_amdgcn_mfma_f32_16x16x32_bf16(*(const LAS bf16x8*)pp, *(const LAS bf16x8*)(vr + ((q * 8) ^ swv)), acco[u], 0, 0, 0);
              acco[u] = __builtin_amdgcn_mfma_f32_16x16x32_bf16(*(const LAS bf16x8*)(pp + 32), *(const LAS bf16x8*)(vr + ((32 + q * 8) ^ swv)), acco[u], 0, 0, 0); }
#pragma unroll
            for (int j = 0; j < 4; ++j) oraw[(row0 + tm * 16 + q * 4 + j) * DM + ocol + (vb + 2 * u) * 16 + r] = acco[u][j];
        }
        {
            const int swk = ((2 * w + (r >> 3)) & 7) << 3;
            const bf16x8 ka0 = *(const LAS bf16x8*)(KhT + (16 * w + r) * 72 + ((q * 8) ^ swk)), ka1 = *(const LAS bf16x8*)(KhT + (16 * w + r) * 72 + ((32 + q * 8) ^ swk));
#pragma unroll
            for (int v2 = 0; v2 < 4; ++v2) {
                accS[v2] = accS[v2] * dec;
                { const int swv = ((2 * v2 + (r >> 3)) & 7) << 3; const LAS bf16_t* vr = Vt + (v2 * 16 + r) * 72;
                  accS[v2] = __builtin_amdgcn_mfma_f32_16x16x32_bf16(ka0, *(const LAS bf16x8*)(vr + ((q * 8) ^ swv)), accS[v2], 0, 0, 0);
                  accS[v2] = __builtin_amdgcn_mfma_f32_16x16x32_bf16(ka1, *(const LAS bf16x8*)(vr + ((32 + q * 8) ^ swv)), accS[v2], 0, 0, 0); }
                u32x2 ws; ws.x = cvt_pk_bf16(accS[v2][0], accS[v2][1]); ws.y = cvt_pk_bf16(accS[v2][2], accS[v2][3]);
                *(LAS u32x2*)(St + (v2 * 16 + r) * 136 + 16 * w + q * 4) = ws;
            }
        }
        __syncthreads();
    }
    float* so = p->out + (RET ? O_PRET : O_PGLA) + ((size_t)(l * NB + b) * NH + h) * 128 * DV;
#pragma unroll
    for (int v2 = 0; v2 < 4; ++v2)
#pragma unroll
        for (int j = 0; j < 4; ++j) so[(size_t)(16 * w + q * 4 + j) * DV + vs * 64 + v2 * 16 + r] = accS[v2][j];
    __syncthreads();
}

__device__ __forceinline__ void s5_prompt_item(ParamsK p, int l, int b, int g, LAS unsigned char* lds) {
    const int tid = fresh_tid(), w = tid >> 6, lane = tid & 63, r = lane & 15, q = lane >> 4;
    LAS f32x2* F = (LAS f32x2*)lds;
    LAS f32x2* Ss = F;
    LAS float* Bu = (LAS float*)(lds + 16384 + w * 12800);
    LAS bf16_t* Xw = (LAS bf16_t*)(lds + 16384 + w * 12800 + 8448);
    const bf16_t* proj = (const bf16_t*)(p->ws + WS_PROJ);
    bf16_t* y5g = (bf16_t*)(p->ws + WS_Y5G);
    const int lg = l * 64 + g;
    const f32x4 av = ((const f32x4*)(p->ws + WS_S5A))[lg * 64 + lane];
    const float abr = av[0], abi = av[1];
    bf16x8 bm[8];
    { const bf16_t* bmt = (const bf16_t*)(p->ws + WS_S5BM) + (size_t)lg * 2 * 128 * 16;
#pragma unroll
      for (int i = 0; i < 8; ++i) bm[i] = *(const bf16x8*)(bmt + (q >> 1) * 2048 + (i * 16 + r) * 16 + (q & 1) * 8); }
    const bf16_t* ubase = proj + ((size_t)b * SEQ + r) * NIN + OFF_U + g * 16 + (q & 1) * 8;
#define S5_UADDR(blk) (ubase + (size_t)((w + 8 * ((blk) >> 2)) * 64 + ((blk) & 3) * 16) * NIN)
#define S5_BLOCK(ub) do { \
        _Pragma("unroll") for (int i = 0; i < 8; ++i) { const f32x4 a4 = __builtin_amdgcn_mfma_f32_16x16x32_bf16(bm[i], ub, (f32x4){0.f, 0.f, 0.f, 0.f}, 0, 0, 0); *(LAS f32x4*)(Bu + r * 132 + i * 16 + q * 4) = a4; } \
        asm volatile("s_waitcnt lgkmcnt(0)" ::: "memory"); } while (0)
#define S5_STEP(t) do { const float bur = Bu[(t) * 132 + lane], bui = Bu[(t) * 132 + 64 + lane]; \
        const float nxr = abr * x[0] - abi * x[1] + bur, nxi = abr * x[1] + abi * x[0] + bui; x[0] = nxr; x[1] = nxi; } while (0)
    bf16x8 ubn = *(const bf16x8*)S5_UADDR(0);
    for (int ci = 0; ci < 4; ++ci) {
        const int c = w + 8 * ci;
        f32x2 x = (f32x2){0.f, 0.f};
        for (int tb = 0; tb < 4; ++tb) {
            const int blk = ci * 4 + tb; const bf16x8 ubc = ubn;
            if (blk + 1 < 16) ubn = *(const bf16x8*)S5_UADDR(blk + 1);
            S5_BLOCK(ubc);
#pragma unroll
            for (int tt = 0; tt < 16; ++tt) S5_STEP(tt);
            asm volatile("s_waitcnt lgkmcnt(0)" ::: "memory");
        }
        F[c * 64 + lane] = x;
    }
    __syncthreads();
    if (w == 0) {
        const float a64r = av[2], a64i = av[3];
        f32x2 s = (f32x2){0.f, 0.f};
        for (int c = 0; c < 32; ++c) { const f32x2 f = F[c * 64 + lane]; Ss[c * 64 + lane] = s;
            const float nr = a64r * s[0] - a64i * s[1] + f[0], ni = a64r * s[1] + a64i * s[0] + f[1]; s[0] = nr; s[1] = ni; }
        p->out[O_PS5R + (size_t)((l * NB + b) * 64 + g) * 64 + lane] = s[0];
        p->out[O_PS5I + (size_t)((l * NB + b) * 64 + g) * 64 + lane] = s[1];
    }
    __syncthreads();
    bf16x8 cmf[4];
    { const bf16_t* cm = (const bf16_t*)(p->ws + WS_S5C) + (size_t)lg * 16 * 128 + r * 128 + q * 8;
#pragma unroll
      for (int ks = 0; ks < 4; ++ks) cmf[ks] = *(const bf16x8*)(cm + ks * 32); }
    const float dsk = p->in[15][l * 1024 + g * 16 + r];
    ubn = *(const bf16x8*)S5_UADDR(0);
    for (int ci = 0; ci < 4; ++ci) {
        const int c = w + 8 * ci;
        f32x2 x = Ss[c * 64 + lane];
        for (int tb = 0; tb < 4; ++tb) {
            const int blk = ci * 4 + tb; const bf16x8 ubc = ubn;
            if (blk + 1 < 16) ubn = *(const bf16x8*)S5_UADDR(blk + 1);
            bf16_t du[4];
#pragma unroll
            for (int j = 0; j < 4; ++j) du[j] = proj[((size_t)b * SEQ + c * 64 + tb * 16 + q * 4 + j) * NIN + OFF_U + g * 16 + r];
            S5_BLOCK(ubc);
#pragma unroll
            for (int tt = 0; tt < 16; ++tt) { S5_STEP(tt); Xw[tt * 136 + lane] = f2bf(x[0]); Xw[tt * 136 + 64 + lane] = f2bf(x[1]); }
            asm volatile("s_waitcnt lgkmcnt(0)" ::: "memory");
            f32x4 acc = (f32x4){0.f, 0.f, 0.f, 0.f};
#pragma unroll
            for (int ks = 0; ks < 4; ++ks) { const bf16x8 a = *(const LAS bf16x8*)(Xw + r * 136 + ks * 32 + q * 8); acc = __builtin_amdgcn_mfma_f32_16x16x32_bf16(a, cmf[ks], acc, 0, 0, 0); }
#pragma unroll
            for (int j = 0; j < 4; ++j) { const int t = tb * 16 + q * 4 + j; const size_t row = (size_t)b * SEQ + c * 64 + t;
                const float y = acc[j] + dsk * bf2f(du[j]);
                y5g[row * 1024 + g * 16 + r] = f2bf(geluf_(y)); }
            asm volatile("s_waitcnt lgkmcnt(0)" ::: "memory");
        }
    }
#undef S5_BLOCK
#undef S5_UADDR
#undef S5_STEP
    __syncthreads();
}

__device__ __forceinline__ void s5_sample(ParamsK p, int l, LAS unsigned char* lds, int wg0, int nwg) {
    const int tid = fresh_tid(), w = tid >> 6, lane = tid & 63, r = lane & 15, q = lane >> 4;
    LAS float* xs = (LAS float*)(lds + w * 512);
    const bf16_t* proj = (const bf16_t*)(p->ws + WS_PROJ);
    bf16_t* y5g = (bf16_t*)(p->ws + WS_Y5G);
    for (int item = (fresh_bid() - wg0) * 8 + w; item < NSAMP * 64; item += nwg * 8) {
        const int b = item >> 6, g = item & 63, lg = l * 64 + g;
        const size_t row = NPROMPT + b;
        const f32x4 av = ((const f32x4*)(p->ws + WS_S5A))[lg * 64 + lane];
        const u32x4 u0 = *(const u32x4*)(proj + row * NIN + OFF_U + g * 16), u1 = *(const u32x4*)(proj + row * NIN + OFF_U + g * 16 + 8);
        const float u[16] = {bflo(u0.x), bfhi(u0.x), bflo(u0.y), bfhi(u0.y), bflo(u0.z), bfhi(u0.z), bflo(u0.w), bfhi(u0.w), bflo(u1.x), bfhi(u1.x), bflo(u1.y), bfhi(u1.y), bflo(u1.z), bfhi(u1.z), bflo(u1.w), bfhi(u1.w)};
        const size_t si = ((size_t)(l * NSAMP + b) * 64 + g) * 64 + lane;
        const float x0r = p->in[2][si], x0i = p->in[3][si];
        float xr = av[0] * x0r - av[1] * x0i, xi = av[0] * x0i + av[1] * x0r;
        const f32x4* bp = (const f32x4*)((const f32x2*)(p->ws + WS_S5B) + (size_t)(lg * 64 + lane) * 16);
#pragma unroll
        for (int i = 0; i < 8; ++i) { const f32x4 t = bp[i]; xr += t[0] * u[2 * i] + t[2] * u[2 * i + 1]; xi += t[1] * u[2 * i] + t[3] * u[2 * i + 1]; }
        p->out[O_SS5R + si] = xr; p->out[O_SS5I + si] = xi;
        xs[lane] = xr; xs[64 + lane] = xi;
        asm volatile("s_waitcnt lgkmcnt(0)" ::: "memory");
        const float* cr = p->in[13] + ((size_t)lg * 16 + r) * 64 + q * 16; const float* ci = p->in[14] + ((size_t)lg * 16 + r) * 64 + q * 16;
        float y = 0.f;
#pragma unroll
        for (int i = 0; i < 4; ++i) { const f32x4 a = *(const f32x4*)(cr + 4 * i), c2 = *(const f32x4*)(ci + 4 * i);
            const f32x4 vr = *(const LAS f32x4*)(xs + q * 16 + 4 * i), vi = *(const LAS f32x4*)(xs + 64 + q * 16 + 4 * i);
            y += a[0] * vr[0] + a[1] * vr[1] + a[2] * vr[2] + a[3] * vr[3] - (c2[0] * vi[0] + c2[1] * vi[1] + c2[2] * vi[2] + c2[3] * vi[3]); }
        y += __shfl_xor(y, 16); y += __shfl_xor(y, 32);
        float ur = 0.f;
#pragma unroll
        for (int i = 0; i < 16; ++i) ur = (r == i) ? u[i] : ur;
        y += p->in[15][l * 1024 + g * 16 + r] * ur;
        if (q == 0) y5g[row * 1024 + g * 16 + r] = f2bf(geluf_(y));
        asm volatile("s_waitcnt lgkmcnt(0)" ::: "memory");
    }
    __syncthreads();
}

template <bool RET>
__device__ __forceinline__ void recur_sample_item(ParamsK p, int l, int item, LAS unsigned char* lds) {
    constexpr int DV = RET ? 128 : 256, NH = RET ? 8 : 4, NV4 = DV / 4, KR = 512 / NV4;
    const int tid = fresh_tid();
    LAS float* qs = (LAS float*)lds; LAS float* ks = qs + 128; LAS float* ds = ks + 128; LAS float* red = ds + 128;
    const bf16_t* proj = (const bf16_t*)(p->ws + WS_PROJ);
    float* oraw = (float*)(p->ws + WS_ORAW);
    const int b = item / NH, h = item % NH;
    const size_t row = NPROMPT + b;
    if (tid < 128) {
        qs[tid] = bf2f(proj[row * NIN + (RET ? OFF_RQ : OFF_GQ) + h * 128 + tid]);
        ks[tid] = bf2f(proj[row * NIN + (RET ? OFF_RK : OFF_GK) + h * 128 + tid]);
        float dec;
        if (RET) dec = 1.0f - exp2f(-5.0f - (float)h);
        else { float lo = p->in[20][l * 512 + h * 128 + tid];
#pragma unroll
            for (int rr = 0; rr < 16; ++rr) lo += bf2f(proj[row * NIN + OFF_GLR + rr]) * p->in[19][((size_t)l * 16 + rr) * 512 + h * 128 + tid];
            dec = __expf(logsigmoidf_(lo) * 0.0625f); }
        ds[tid] = dec;
    }
    __syncthreads();
    const int vq = tid % NV4, kr = tid / NV4;
    const u32x2 vb = *(const u32x2*)(proj + row * NIN + (RET ? OFF_RV : OFF_GV) + h * DV + vq * 4);
    const f32x4 v4 = (f32x4){bflo(vb.x), bfhi(vb.x), bflo(vb.y), bfhi(vb.y)};
    const size_t sbase = ((size_t)(l * NSAMP + b) * NH + h) * 128 * DV;
    const float* s0 = p->in[RET ? 5 : 4] + sbase; float* sn = p->out + (RET ? O_SRET : O_SGLA) + sbase;
    f32x4 o4 = (f32x4){0.f, 0.f, 0.f, 0.f};
#pragma unroll 8
    for (int k = kr; k < 128; k += KR) {
        const f32x4 s = __builtin_nontemporal_load((const f32x4*)(s0 + (size_t)k * DV + vq * 4));
        const f32x4 nw = s * ds[k] + v4 * ks[k];
        __builtin_nontemporal_store(nw, (f32x4*)(sn + (size_t)k * DV + vq * 4));
        o4 += nw * qs[k];
    }
    *(LAS f32x4*)(red + kr * DV + vq * 4) = o4;
    __syncthreads();
    if (tid < DV) { float o = 0.f;
#pragma unroll
        for (int i = 0; i < KR; ++i) o += red[i * DV + tid];
        oraw[row * DM + (RET ? 1024 + h * 128 : h * 256) + tid] = o; }
    __syncthreads();
}

__device__ __forceinline__ void phase_mixers(ParamsK p, int l, LAS unsigned char* lds) {
    const int bid = fresh_bid(), G = gridDim.x, half = G >> 1;
    if (bid < half) {
        for (int item = bid; item < 128; item += half) {
            if (item < 64) recur_item<false>(p, l, item >> 4, (item >> 2) & 3, item & 3, lds);
            else { const int it = item - 64; recur_item<true>(p, l, it >> 4, (it >> 1) & 7, it & 1, lds); }
        }
    } else {
        for (int rep = 0; rep < REP_S5; ++rep) for (int item = bid - half; item < 256; item += G - half) s5_prompt_item(p, l, item >> 6, item & 63, lds);
        s5_sample(p, l, lds, half, G - half);
    }
    unsigned* ctr = (unsigned*)(p->ws + WS_BAR) + 3584 + 64 * l;
    LAS int* slot = (LAS int*)(lds + 65536);
    for (;;) {
        if (fresh_tid() == 0) slot[0] = (int)__hip_atomic_fetch_add(ctr, 1u, __ATOMIC_RELAXED, __HIP_MEMORY_SCOPE_AGENT);
        __syncthreads();
        const int item = slot[0];
        __syncthreads();
        if (item >= 1536) break;
        if (item < 512) recur_sample_item<false>(p, l, item, lds); else recur_sample_item<true>(p, l, item - 512, lds);
    }
}

__device__ __forceinline__ void post_norms(ParamsK p, int l) {
    const int tid = fresh_tid();
    const float* oraw = (const float*)(p->ws + WS_ORAW);
    const bf16_t* proj = (const bf16_t*)(p->ws + WS_PROJ);
    bf16_t* agla = (bf16_t*)(p->ws + WS_AGLA); bf16_t* aret = (bf16_t*)(p->ws + WS_ARET);
    const bool gla = tid < 256;
    const int col = gla ? tid * 4 : (tid - 256) * 4;
    f32x4 gn = (f32x4){1.f, 1.f, 1.f, 1.f};
    if (gla) gn = *(const f32x4*)(p->in[21] + l * 256 + (col & 255));
    const int bid = fresh_bid();
    if (bid >= 132 && bid < 231) return;
    const int widx = bid < 132 ? bid : bid - 99;
    const int G = (int)gridDim.x - 99;
    for (int row0 = widx; row0 < MROWS; row0 += 4 * G) {
        f32x4 o[4]; u32x2 gb[4];
#pragma unroll
        for (int u = 0; u < 4; ++u) { const int row = row0 + u * G < MROWS ? row0 + u * G : row0;
            o[u] = *(const f32x4*)(oraw + (size_t)row * DM + tid * 4); gb[u] = *(const u32x2*)(proj + (size_t)row * NIN + (gla ? OFF_GR : OFF_RG) + col); }
#pragma unroll
        for (int u = 0; u < 4; ++u) {
            const int row = row0 + u * G; if (row >= MROWS) break;
            u32x2 w;
            if (gla) {
                float ss = o[u][0] * o[u][0] + o[u][1] * o[u][1] + o[u][2] * o[u][2] + o[u][3] * o[u][3];
#pragma unroll
                for (int s2 = 32; s2 > 0; s2 >>= 1) ss += __shfl_xor(ss, s2);
                const float rs = 1.0f / sqrtf(ss * (1.0f / 256.0f) + 1e-6f);
                w.x = cvt_pk_bf16(o[u][0] * rs * gn[0] * bflo(gb[u].x), o[u][1] * rs * gn[1] * bfhi(gb[u].x)); w.y = cvt_pk_bf16(o[u][2] * rs * gn[2] * bflo(gb[u].y), o[u][3] * rs * gn[3] * bfhi(gb[u].y));
                *(u32x2*)(agla + (size_t)row * 1024 + col) = w;
            } else {
                float sm = o[u][0] + o[u][1] + o[u][2] + o[u][3];
#pragma unroll
                for (int s2 = 16; s2 > 0; s2 >>= 1) sm += __shfl_xor(sm, s2);
                const float mu = sm * (1.0f / 128.0f);
                const f32x4 d = o[u] - mu;
                float ss = d[0] * d[0] + d[1] * d[1] + d[2] * d[2] + d[3] * d[3];
#pragma unroll
                for (int s2 = 16; s2 > 0; s2 >>= 1) ss += __shfl_xor(ss, s2);
                const float rs = 1.0f / sqrtf(ss * (1.0f / 128.0f) + 1e-6f);
                w.x = cvt_pk_bf16(d[0] * rs * bflo(gb[u].x), d[1] * rs * bfhi(gb[u].x)); w.y = cvt_pk_bf16(d[2] * rs * bflo(gb[u].y), d[3] * rs * bfhi(gb[u].y));
                *(u32x2*)(aret + (size_t)row * 1024 + col) = w;
            }
        }
    }
}


__device__ __forceinline__ void skinny_resid(const bf16_t* A, int lda, const bf16_t* Wt, int ldb, int K, const XSrc res, float* out, LAS unsigned char* lds) {
    const int tid = fresh_tid(), w = tid >> 6, lane = tid & 63, r = lane & 15, q = lane >> 4;
    LAS float* red = (LAS float*)lds;
    for (int piece = fresh_bid(); piece < 256; piece += gridDim.x) {
        const int rh = piece & 1, cg = piece >> 1;
        const bf16_t* ap = A + (size_t)(NPROMPT + rh * 64 + r) * lda + q * 8;
        const bf16_t* bp = Wt + (size_t)(cg * 16 + r) * ldb + q * 8;
        const int ksper = K / 256, k0 = w * ksper * 32;
        f32x4 acc[4];
#pragma unroll
        for (int mt = 0; mt < 4; ++mt) acc[mt] = (f32x4){0.f, 0.f, 0.f, 0.f};
#pragma unroll 4
        for (int ks = 0; ks < ksper; ++ks) {
            const int k = k0 + ks * 32;
            const bf16x8 b = *(const bf16x8*)(bp + k);
            bf16x8 a[4];
#pragma unroll
            for (int mt = 0; mt < 4; ++mt) a[mt] = *(const bf16x8*)(ap + (size_t)mt * 16 * lda + k);
#pragma unroll
            for (int mt = 0; mt < 4; ++mt) acc[mt] = __builtin_amdgcn_mfma_f32_16x16x32_bf16(a[mt], b, acc[mt], 0, 0, 0);
        }
#pragma unroll
        for (int mt = 0; mt < 4; ++mt) *(LAS f32x4*)(red + w * 1024 + (mt * 64 + lane) * 4) = acc[mt];
        __syncthreads();
#pragma unroll
        for (int h = 0; h < 2; ++h) {
            const int e = tid + h * 512;
            float sum = 0.f;
#pragma unroll
            for (int ww = 0; ww < 8; ++ww) sum += red[ww * 1024 + e];
            const int mt = e >> 8, ln = (e >> 2) & 63, j = e & 3;
            const int row = NPROMPT + rh * 64 + mt * 16 + (ln >> 4) * 4 + j, col = cg * 16 + (ln & 15);
            out[(size_t)row * DM + col] = res.row(row)[col] + sum;
        }
        __syncthreads();
    }
}


__device__ __forceinline__ void skinny_merge(ParamsK p, int l, LAS unsigned char* lds) {
    const int tid = fresh_tid(), w = tid >> 6, lane = tid & 63, r = lane & 15, q = lane >> 4;
    LAS float* red = (LAS float*)lds;
    const bf16_t* proj = (const bf16_t*)(p->ws + WS_PROJ); bf16_t* O = (bf16_t*)(p->ws + WS_MERGED);
    for (int piece = fresh_bid(); piece < 256; piece += gridDim.x) {
        const int rh = piece & 1, cg = piece >> 1;
#pragma unroll
        for (int z = 0; z < 3; ++z) {
            const bf16_t* A = (const bf16_t*)(p->ws + (z == 0 ? WS_AS5 : (z == 1 ? WS_AGLA : WS_ARET)));
            const bf16_t* Wt = (const bf16_t*)(p->ws + (z == 0 ? WS_WS5O : (z == 1 ? WS_WGLAO : WS_WRETO)) + l * SZ_WBR);
            const bf16_t* ap = A + (size_t)(NPROMPT + rh * 64 + r) * 1024 + q * 8 + w * 128;
            const bf16_t* bp = Wt + (size_t)(cg * 16 + r) * 1024 + q * 8 + w * 128;
            f32x4 acc[4];
#pragma unroll
            for (int mt = 0; mt < 4; ++mt) acc[mt] = (f32x4){0.f, 0.f, 0.f, 0.f};
#pragma unroll
            for (int ks = 0; ks < 4; ++ks) {
                const bf16x8 b = *(const bf16x8*)(bp + ks * 32);
#pragma unroll
                for (int mt = 0; mt < 4; ++mt) { const bf16x8 a = *(const bf16x8*)(ap + (size_t)mt * 16 * 1024 + ks * 32); acc[mt] = __builtin_amdgcn_mfma_f32_16x16x32_bf16(a, b, acc[mt], 0, 0, 0); }
            }
#pragma unroll
            for (int mt = 0; mt < 4; ++mt) *(LAS f32x4*)(red + (z * 8 + w) * 1024 + (mt * 64 + lane) * 4) = acc[mt];
        }
        __syncthreads();
#pragma unroll
        for (int h = 0; h < 2; ++h) {
            const int e = tid + h * 512;
            const int mt = e >> 8, ln = (e >> 2) & 63, j = e & 3;
            const int row = NPROMPT + rh * 64 + mt * 16 + (ln >> 4) * 4 + j, col = cg * 16 + (ln & 15);
            float tot = 0.f;
#pragma unroll
            for (int z = 0; z < 3; ++z) { float sum = 0.f;
#pragma unroll
                for (int ww = 0; ww < 8; ++ww) sum += red[(z * 8 + ww) * 1024 + e];
                tot += sum * bf2f(proj[(size_t)row * NIN + OFF_MG + z * 2048 + col]); }
            O[(size_t)row * DM + col] = f2bf(tot);
        }
        __syncthreads();
    }
}

#define XB_TMO      128
#define XB_XCNT(j)  (256  + 64 * (j))
#define XB_XSUB(j)  (1280 + 64 * (j))
#define XB_XGEN(j)  (2304 + 64 * (j))
#define XB_TOP      3328
#define XB_TOPGEN   3392
#define XCD_BAR_WORDS 3456
#define XB_SPIN_CAP (1u << 18)
__device__ __forceinline__ unsigned xb_ld(unsigned* p)              { return __hip_atomic_load(p, __ATOMIC_RELAXED, __HIP_MEMORY_SCOPE_AGENT); }
__device__ __forceinline__ unsigned xb_add(unsigned* p, unsigned v) { return __hip_atomic_fetch_add(p, v, __ATOMIC_RELAXED, __HIP_MEMORY_SCOPE_AGENT); }
__device__ __forceinline__ unsigned xb_xcc_id() { return (unsigned)__builtin_amdgcn_s_getreg((3 << 11) | 20) & 0xFu; }
#define XB_SPIN(cond, bar) do { unsigned _sp = 0; while (cond) { __builtin_amdgcn_s_sleep(1); \
    if ((++_sp & 255u) == 0u) { if (xb_ld(&(bar)[XB_TMO])) break; if (_sp > XB_SPIN_CAP) { atomicAdd(&(bar)[XB_TMO], 1u); break; } } } } while (0)
struct XcdBarrier { unsigned* bar; unsigned x; volatile LAS unsigned* st; };
__device__ __forceinline__ XcdBarrier xcd_barrier_post(unsigned* bar, volatile LAS unsigned* st) {
    XcdBarrier b; b.bar = bar; b.x = xb_xcc_id(); b.st = st;
    if (threadIdx.x == 0) (void)xb_add(&bar[XB_XCNT(b.x)], 1u);
    return b;
}
__device__ __forceinline__ void xcd_barrier_complete(unsigned* bar, unsigned x, unsigned& nloc, unsigned& nx) {
    const unsigned G = gridDim.x * gridDim.y * gridDim.z;
    unsigned sum, cnt, mine, sp = 0u;
    for (;;) {
        sum = 0u; cnt = 0u; mine = 0u;
#pragma unroll
        for (unsigned j = 0; j < 16; ++j) { const unsigned c = xb_ld(&bar[XB_XCNT(j)]); sum += c; cnt += (c > 0u) ? 1u : 0u; mine = (j == x) ? c : mine; }
        if (sum == G) break;
        __builtin_amdgcn_s_sleep(1);
        if ((++sp & 255u) == 0u) { if (xb_ld(&bar[XB_TMO])) break; if (sp > XB_SPIN_CAP) { atomicAdd(&bar[XB_TMO], 1u); break; } }
    }
    nloc = mine > 0u ? mine : 1u; nx = cnt > 0u ? cnt : 1u;
}
__device__ __forceinline__ void xcd_barrier(const XcdBarrier& b) {
    asm volatile("s_waitcnt vmcnt(0)" ::: "memory");
    __syncthreads();
    if (threadIdx.x == 0) {
        unsigned* bar = b.bar;
        __builtin_amdgcn_s_waitcnt(0);
        unsigned nloc = b.st[0], nx = b.st[1];
        if (nloc == 0u) { xcd_barrier_complete(bar, b.x, nloc, nx); b.st[0] = nloc; b.st[1] = nx; }
        const unsigned old = xb_add(&bar[XB_XSUB(b.x)], 1u);
        const unsigned gen = old / nloc;
        if (old + 1u == (gen + 1u) * nloc) {
            __builtin_amdgcn_fence(__ATOMIC_RELEASE, "agent");
            asm volatile("s_waitcnt vmcnt(0)" ::: "memory");
            const unsigned og = xb_add(&bar[XB_TOP], 1u);
            const unsigned tg = og / nx;
            if (og + 1u == (tg + 1u) * nx) xb_add(&bar[XB_TOPGEN], 1u);
            else XB_SPIN(xb_ld(&bar[XB_TOPGEN]) == tg, bar);
            __builtin_amdgcn_fence(__ATOMIC_ACQUIRE, "agent");
            xb_add(&bar[XB_XGEN(b.x)], 1u);
            asm volatile("s_waitcnt vmcnt(0)" ::: "memory");
        } else {
            XB_SPIN(xb_ld(&bar[XB_XGEN(b.x)]) == gen, bar);
            __builtin_amdgcn_fence(__ATOMIC_ACQUIRE, "agent");
            asm volatile("s_waitcnt vmcnt(0)" ::: "memory");
        }
    }
    __syncthreads();
}
#define GSYNC() do { XcdBarrier _b; _b.bar = (unsigned*)(fresh_params()->ws + WS_BAR); _b.x = xb_xcc_id(); _b.st = (volatile LAS unsigned*)(lds + 131072); xcd_barrier(_b); } while (0)

__global__ void __launch_bounds__(512) hybrid_fwd(Params p_unused) {
    extern __shared__ __attribute__((aligned(16))) unsigned char lds_raw[];
    LAS unsigned char* lds = (LAS unsigned char*)lds_raw;
    cg::grid_group grid = cg::this_grid();
    const int G = gridDim.x;

    if (threadIdx.x < 4) ((volatile LAS unsigned*)(lds + 131072))[threadIdx.x] = 0u;
    __syncthreads();
    (void)xcd_barrier_post((unsigned*)(fresh_params()->ws + WS_BAR), (volatile LAS unsigned*)(lds + 131072));
    for (int rep = 0; rep < REP_PRE; ++rep) phase_prepass(fresh_params(), lds);
    if (fresh_params()->ws == nullptr) grid.sync();
    GSYNC();
    for (int rep = 0; rep < REP_SYNC; ++rep) GSYNC();
#pragma unroll 1
    for (int l = 0; l < 2; ++l) {
        {
            ParamsK p = fresh_params();
            pg8::Gemm g; g.A0 = g.A1 = g.A2 = (const bf16_t*)(p->ws + WS_XN); g.B0 = g.B1 = g.B2 = (const bf16_t*)(p->ws + WS_WIN + l * SZ_WIN); g.lda = 2048; g.ldb = 2048; g.K = 2048;
            pg8::TileOrder S; S.init(MP, 54 * 256, G, fresh_bid(), 1); S.cut = 53; S.shift = 3;
            EpiInProj E; E.O = (bf16_t*)(p->ws + WS_PROJ); E.rot = (const float*)(p->ws + WS_ROT);
            for (int rep = 0; rep < REP_INPROJ; ++rep) pg8::gemm_phase(lds, g, S, E);
        }
        GSYNC();
        phase_gates(fresh_params(), l);
        GSYNC();
        for (int rep = 0; rep < REP_MIX; ++rep) phase_mixers(fresh_params(), l, lds);
        GSYNC();
        {
            ParamsK p = fresh_params();
            pg8::Gemm g; g.A0 = g.A1 = g.A2 = (const bf16_t*)(p->ws + WS_Y5G); g.B0 = g.B1 = g.B2 = (const bf16_t*)(p->ws + WS_WGLU + l * SZ_WGLU); g.lda = 1024; g.ldb = 1024; g.K = 1024;
            pg8::TileOrder S; S.init(MP, 1024, G, fresh_bid(), 1);
            EpiGlu E; E.O = (bf16_t*)(p->ws + WS_AS5); E.Y = (const bf16_t*)(p->ws + WS_Y5G); E.bias = p->in[17] + l * 1024;
            for (int rep = 0; rep < REP_POST; ++rep) { pg8::gemm_phase(lds, g, S, E);
            {
                ParamsK p2 = fresh_params();
                pg8::Gemm g2; g2.A0 = g2.A1 = g2.A2 = (const bf16_t*)(p2->ws + WS_XN); g2.B0 = g2.B1 = g2.B2 = (const bf16_t*)(p2->ws + WS_WIN + l * SZ_WIN); g2.lda = 2048; g2.ldb = 2048; g2.K = 2048;
                const int c2 = fresh_bid() - 132;
                if (c2 >= 0) {
                    pg8::TileOrder S2; S2.init(MP, 3 * 256, (int)gridDim.x - 132, c2, 1); S2.cut = 0; S2.shift = 53;
                    EpiInProj E2; E2.O = (bf16_t*)(p2->ws + WS_PROJ); E2.rot = (const float*)(p2->ws + WS_ROT);
                    pg8::gemm_phase(lds, g2, S2, E2);
                }
            }
            post_norms(fresh_params(), l); }
        }
        GSYNC();
        {
            ParamsK p = fresh_params();
            pg8::Gemm g; g.A0 = (const bf16_t*)(p->ws + WS_AS5); g.A1 = (const bf16_t*)(p->ws + WS_AGLA); g.A2 = (const bf16_t*)(p->ws + WS_ARET);
            g.B0 = (const bf16_t*)(p->ws + WS_WS5O + l * SZ_WBR); g.B1 = (const bf16_t*)(p->ws + WS_WGLAO + l * SZ_WBR); g.B2 = (const bf16_t*)(p->ws + WS_WRETO + l * SZ_WBR);
            g.lda = 1024; g.ldb = 1024; g.K = 1024;
            pg8::TileOrder S; S.init(NPROMPT, DM, G, fresh_bid(), 3);
            EpiMerge E; E.O = (bf16_t*)(p->ws + WS_MERGED); E.proj = (const bf16_t*)(p->ws + WS_PROJ);
            for (int rep = 0; rep < REP_MG; ++rep) { pg8::gemm_phase(lds, g, S, E); skinny_merge(fresh_params(), l, lds); }
        }
        GSYNC();
        {
            ParamsK p = fresh_params();
            pg8::Gemm g; g.A0 = g.A1 = g.A2 = (const bf16_t*)(p->ws + WS_MERGED); g.B0 = g.B1 = g.B2 = (const bf16_t*)(p->ws + WS_WMIX + l * SZ_WMIX); g.lda = 2048; g.ldb = 2048; g.K = 2048;
            pg8::TileOrder S; S.init(NPROMPT, DM, G, fresh_bid(), 1);
            EpiResid E; E.O = (float*)(p->ws + WS_X1); E.zero = (DBG_ZMASK >> 4) & 1;
            const float* X2 = (const float*)(p->ws + WS_X2);
            if (l == 0) { E.res.a = p->in[0]; E.res.b = p->in[1]; E.res.split = NPROMPT; E.res.valid = MROWS; } else { E.res.a = X2; E.res.b = X2; E.res.split = MP; E.res.valid = MP; }
            for (int rep = 0; rep < REP_MO; ++rep) { pg8::gemm_phase(lds, g, S, E);
                skinny_resid((const bf16_t*)(p->ws + WS_MERGED), 2048, (const bf16_t*)(p->ws + WS_WMIX + l * SZ_WMIX), 2048, 2048, E.res, E.O, lds); }
        }
        GSYNC();
        { ParamsK p = fresh_params(); const float* X1 = (const float*)(p->ws + WS_X1); XSrc s; s.a = X1; s.b = X1; s.split = MP; s.valid = MP; for (int rep = 0; rep < REP_NORM; ++rep) norm_rows(s, p->in[25] + l * DM, (bf16_t*)(p->ws + WS_XN), nullptr); }
        GSYNC();
        {
            ParamsK p = fresh_params();
            pg8::Gemm g; g.A0 = g.A1 = g.A2 = (const bf16_t*)(p->ws + WS_XN); g.B0 = g.B1 = g.B2 = (const bf16_t*)(p->ws + WS_WGU + l * SZ_WGU); g.lda = 2048; g.ldb = 2048; g.K = 2048;
            pg8::TileOrder S; S.init(MP, 11264, G, fresh_bid(), 1);
            EpiFfnUp E; E.O = (bf16_t*)(p->ws + WS_FF);
            for (int rep = 0; rep < REP_UP; ++rep) pg8::gemm_phase(lds, g, S, E);
        }
        GSYNC();
        {
            ParamsK p = fresh_params();
            const float* X1 = (const float*)(p->ws + WS_X1);
            pg8::Gemm g; g.A0 = g.A1 = g.A2 = (const bf16_t*)(p->ws + WS_FF); g.B0 = g.B1 = g.B2 = (const bf16_t*)(p->ws + WS_WDN + l * SZ_WDN); g.lda = DFF; g.ldb = DFF; g.K = DFF;
            pg8::TileOrder S; S.init(NPROMPT, DM, G, fresh_bid(), 1);
            EpiResid E; E.O = (float*)(p->ws + WS_X2); E.zero = (DBG_ZMASK >> 3) & 1; E.res.a = X1; E.res.b = X1; E.res.split = MP; E.res.valid = MP;
            for (int rep = 0; rep < REP_DN; ++rep) { pg8::gemm_phase(lds, g, S, E);
                skinny_resid((const bf16_t*)(p->ws + WS_FF), DFF, (const bf16_t*)(p->ws + WS_WDN + l * SZ_WDN), DFF, DFF, E.res, E.O, lds); }
        }
        GSYNC();
        { ParamsK p = fresh_params(); const float* X2 = (const float*)(p->ws + WS_X2); XSrc s; s.a = X2; s.b = X2; s.split = MP; s.valid = MP;
          if (l == 0) norm_rows(s, p->in[6] + DM, (bf16_t*)(p->ws + WS_XN), nullptr); else norm_rows(s, p->in[29], nullptr, p->out + O_Y); }
        if (l == 0) GSYNC();
    }
}

extern "C" void kernel_launch(void* const* d_in, const int* in_sizes, int n_in, void* d_out, int out_size, void* d_ws, size_t ws_size, hipStream_t stream) {
    static int grid_blocks = 0;
    if (grid_blocks == 0) {
        if (n_in != 30 || ws_size < WS_TOTAL) { fprintf(stderr, "kernel_launch: unexpected n_in %d / ws_size %zu (need %zu)\n", n_in, ws_size, (size_t)WS_TOTAL); grid_blocks = -1; return; }
        int dev = 0, cus = 0, per_cu = 0;
        (void)hipGetDevice(&dev);
        (void)hipDeviceGetAttribute(&cus, hipDeviceAttributeMultiprocessorCount, dev);
        if (hipFuncSetAttribute((const void*)hybrid_fwd, hipFuncAttributeMaxDynamicSharedMemorySize, LDS_BYTES) != hipSuccess) { fprintf(stderr, "kernel_launch: hipFuncSetAttribute failed\n"); grid_blocks = -1; return; }
        if (hipOccupancyMaxActiveBlocksPerMultiprocessor(&per_cu, (const void*)hybrid_fwd, 512, LDS_BYTES) != hipSuccess || per_cu < 1) { fprintf(stderr, "kernel_launch: occupancy query gave %d\n", per_cu); per_cu = 1; }
        (void)hipGetLastError();
        grid_blocks = cus * 1;
    }
    if (grid_blocks < 0) return;
    if (hipMemsetAsync((char*)d_ws + WS_BAR, 0, 16384, stream) != hipSuccess) { fprintf(stderr, "kernel_launch: memset of the barrier words failed\n"); return; }
    Params p{};
    for (int i = 0; i < 30; ++i) p.in[i] = (const float*)d_in[i];
    p.out = (float*)d_out; p.ws = (unsigned char*)d_ws;
    void* args[] = {&p};
    hipError_t e = hipLaunchCooperativeKernel((const void*)hybrid_fwd, dim3(grid_blocks), dim3(512), args, LDS_BYTES, stream);
    if (e != hipSuccess) fprintf(stderr, "cooperative launch failed: %s (grid %d)\n", hipGetErrorString(e), grid_blocks);
}
```
